# Optimizing an MI355X kernel written in HIP

```python
import jax, jax.numpy as jnp
from jax import lax
import numpy as np

D_MODEL = 1024
BATCH = 8
SEQ = 2048
DEPTH = 2

HEAD_DIM = 64
N_HEADS = D_MODEL // HEAD_DIM
N_SB_HEADS = N_HEADS // 2
N_DSA_HEADS = N_HEADS - N_SB_HEADS
SB_WIDTH = N_SB_HEADS * HEAD_DIM
DSA_WIDTH = N_DSA_HEADS * HEAD_DIM
MIX_WIDTH = SB_WIDTH + DSA_WIDTH
KV_LORA = D_MODEL // 4
N_IDX_HEADS = 4
IDX_DIM = 64
TOPK_MAX = 256
Q_BLOCK = 128
D_FF = -(-8 * D_MODEL // (3 * 256)) * 256
RMS_EPS = 1e-6
IN_SIZES = (SB_WIDTH, SB_WIDTH, SB_WIDTH,
            DSA_WIDTH, KV_LORA,
            N_IDX_HEADS * IDX_DIM, IDX_DIM,
            N_IDX_HEADS)
IN_COLS = sum(IN_SIZES)

kernel_name = "hybrid_stickbreak_dsa_adaln_block"


def _rmsnorm(x, gain):
    xf = x.astype(jnp.float32)
    y = xf * lax.rsqrt(jnp.mean(xf * xf, axis=-1, keepdims=True) + RMS_EPS)
    return (y * gain.astype(jnp.float32)).astype(x.dtype)


def _modulate(h, shift, scale):
    return h * (1.0 + scale[:, None, :]) + shift[:, None, :]


def _alibi_slopes(n):
    return 2.0 ** (-8.0 * jnp.arange(1, n + 1, dtype=jnp.float32) / n)


def _stick_breaking_attention(q, k, v):
    B, S, H, dh = q.shape
    scale = dh ** -0.5
    outs = []
    for i in range(S // Q_BLOCK):
        q0, end = i * Q_BLOCK, (i + 1) * Q_BLOCK
        z = jnp.einsum('bthd,bshd->bhts', q[:, q0:end], k[:, :end]).astype(jnp.float32) * scale
        t_pos = q0 + jnp.arange(Q_BLOCK)[:, None]
        s_pos = jnp.arange(end)[None, :]
        causal = s_pos < t_pos
        log_1m_beta = jnp.where(causal, jax.nn.log_sigmoid(-z), 0.0)
        tail = lax.cumsum(log_1m_beta, axis=3, reverse=True) - log_1m_beta
        A = jnp.where(causal, jnp.exp(jax.nn.log_sigmoid(z) + tail), 0.0)
        outs.append(jnp.einsum('bhts,bshd->bthd', A.astype(v.dtype), v[:, :end]))
    return jnp.concatenate(outs, axis=1)


def _dsa_attention(q, k, v, q_idx, k_idx, w_idx, slopes, topk):
    B, S, H, dh = q.shape
    scale = dh ** -0.5
    idx_q_scale = IDX_DIM ** -0.5
    idx_w_scale = N_IDX_HEADS ** -0.5
    b_idx = jnp.arange(B)[:, None, None]
    s_pos = jnp.arange(S)

    def block(i):
        q0 = i * Q_BLOCK
        qb = lax.dynamic_slice_in_dim(q, q0, Q_BLOCK, axis=1)
        qib = lax.dynamic_slice_in_dim(q_idx, q0, Q_BLOCK, axis=1)
        wib = lax.dynamic_slice_in_dim(w_idx, q0, Q_BLOCK, axis=1)
        t_pos = q0 + jnp.arange(Q_BLOCK)
        causal = s_pos[None, :] <= t_pos[:, None]
        idx_logits = jnp.einsum('bthd,bsd->btsh', qib, k_idx).astype(jnp.float32) * idx_q_scale
        score = jnp.einsum('btsh,bth->bts', jax.nn.relu(idx_logits),
                           wib.astype(jnp.float32) * idx_w_scale)
        score = jnp.where(causal[None], score, -jnp.inf)
        _, sel = lax.top_k(score, topk)
        k_sel = k[b_idx, sel]
        v_sel = v[b_idx, sel]
        valid = sel <= t_pos[None, :, None]
        dist = (t_pos[None, :, None] - sel).astype(jnp.float32)
        logits = jnp.einsum('bthd,btkd->bhtk', qb, k_sel).astype(jnp.float32) * scale
        logits = logits - slopes[None, :, None, None] * dist[:, None]
        logits = jnp.where(valid[:, None], logits, -jnp.inf)
        p = jax.nn.softmax(logits, axis=-1)
        return jnp.einsum('bhtk,btkd->bthd', p.astype(v.dtype), v_sel)

    out = lax.map(block, jnp.arange(S // Q_BLOCK))
    return jnp.moveaxis(out, 0, 1).reshape(B, S, H, dh)


def _hybrid_mixer(h, w_in, kv_gain, w_uk, w_uv, sb_out_gain, dsa_out_gain, w_o, slopes, topk):
    B, S, _ = h.shape
    proj = h @ w_in
    sb_q, sb_k, sb_v, dsa_q, kv_lat, idx_q, idx_k, idx_w = jnp.split(
        proj, np.cumsum(IN_SIZES)[:-1], axis=-1)
    sb_heads = lambda t: t.reshape(B, S, N_SB_HEADS, HEAD_DIM)
    o_sb = _stick_breaking_attention(sb_heads(sb_q), sb_heads(sb_k), sb_heads(sb_v))
    kv = _rmsnorm(kv_lat, kv_gain)
    k_d = kv @ w_uk
    v_d = kv @ w_uv
    o_dsa = _dsa_attention(dsa_q.reshape(B, S, N_DSA_HEADS, HEAD_DIM), k_d, v_d,
                           idx_q.reshape(B, S, N_IDX_HEADS, IDX_DIM), idx_k, idx_w,
                           slopes, topk)
    o = jnp.concatenate([_rmsnorm(o_sb.reshape(B, S, SB_WIDTH), sb_out_gain),
                         _rmsnorm(o_dsa.reshape(B, S, DSA_WIDTH), dsa_out_gain)], axis=-1)
    return o @ w_o


def _swiglu(h, w_gate, w_up, w_down):
    return (jax.nn.silu(h @ w_gate) * (h @ w_up)) @ w_down


def setup_inputs(seed: int = 0) -> dict:
    key = jax.random.key(seed)
    ks = jax.random.split(key, 20)
    nrm = lambda k, shape, s: jax.random.normal(k, shape, jnp.float32) * s
    gain = lambda k, shape: 1.0 + nrm(k, shape, 0.02)
    L, D = DEPTH, D_MODEL
    return {
        "x": nrm(ks[0], (BATCH, SEQ, D), 1.0),
        "c": nrm(ks[1], (BATCH, D), 1.0),
        "w_mod": nrm(ks[2], (L, D, 6 * D), 0.5 * D ** -0.5),
        "b_mod": nrm(ks[3], (L, 6 * D), 0.02),
        "norm1_gain": gain(ks[4], (L, D)),
        "norm2_gain": gain(ks[5], (L, D)),
        "w_in": nrm(ks[6], (L, D, IN_COLS), D ** -0.5),
        "kv_gain": gain(ks[7], (L, KV_LORA)),
        "w_uk": nrm(ks[8], (L, KV_LORA, HEAD_DIM), KV_LORA ** -0.5),
        "w_uv": nrm(ks[9], (L, KV_LORA, HEAD_DIM), KV_LORA ** -0.5),
        "sb_out_gain": gain(ks[10], (L, SB_WIDTH)),
        "dsa_out_gain": gain(ks[11], (L, DSA_WIDTH)),
        "w_o": nrm(ks[12], (L, MIX_WIDTH, D), MIX_WIDTH ** -0.5),
        "w_gate": nrm(ks[13], (L, D, D_FF), D ** -0.5),
        "w_up": nrm(ks[14], (L, D, D_FF), D ** -0.5),
        "w_down": nrm(ks[15], (L, D_FF, D), D_FF ** -0.5),
        "w_mod_final": nrm(ks[16], (D, 2 * D), 0.5 * D ** -0.5),
        "b_mod_final": nrm(ks[17], (2 * D,), 0.02),
        "final_gain": gain(ks[18], (D,)),
    }


def reference(x, c, w_mod, b_mod, norm1_gain, norm2_gain, w_in, kv_gain, w_uk, w_uv,
              sb_out_gain, dsa_out_gain, w_o, w_gate, w_up, w_down,
              w_mod_final, b_mod_final, final_gain):
    S = x.shape[1]
    topk = min(TOPK_MAX, S // 4)
    slopes = _alibi_slopes(N_DSA_HEADS)
    c_act = jax.nn.silu(c)
    for l in range(DEPTH):
        mod = c_act @ w_mod[l] + b_mod[l]
        sh1, sc1, g1, sh2, sc2, g2 = jnp.split(mod, 6, axis=-1)
        h = _modulate(_rmsnorm(x, norm1_gain[l]), sh1, sc1)
        x = x + g1[:, None, :] * _hybrid_mixer(h, w_in[l], kv_gain[l], w_uk[l], w_uv[l],
                                               sb_out_gain[l], dsa_out_gain[l], w_o[l],
                                               slopes, topk)
        h = _modulate(_rmsnorm(x, norm2_gain[l]), sh2, sc2)
        x = x + g2[:, None, :] * _swiglu(h, w_gate[l], w_up[l], w_down[l])
    sh_f, sc_f = jnp.split(c_act @ w_mod_final + b_mod_final, 2, axis=-1)
    return _modulate(_rmsnorm(x, final_gain), sh_f, sc_f)
```

```cpp
#include <hip/hip_runtime.h>
#include <cstdio>
#include <cstdint>
#include <cmath>

namespace {
constexpr int D_MODEL = 1024, BATCH = 8, SEQ = 2048, DEPTH = 2;
constexpr int M = BATCH * SEQ;
constexpr int IN_COLS = 2628, D_FF = 2816, KV_LORA = 256;
constexpr int C_SBQ = 0, C_SBK = 512, C_SBV = 1024, C_DQ = 1536, C_KVL = 2048, C_IQ = 2304, C_IK = 2560, C_IW = 2624;
constexpr float RMS_EPS = 1e-6f;
constexpr size_t MiB = 1u << 20;
constexpr size_t WS_MOD = 0;
constexpr size_t WS_H = 1 * MiB;
constexpr size_t WS_PROJ = 65 * MiB;
constexpr size_t WS_KD = 242 * MiB;
constexpr size_t WS_VD = 246 * MiB;
constexpr size_t WS_MASK = 250 * MiB;

__global__ void k_silu(const float* __restrict__ c, float* __restrict__ o, int n) {
    int i = blockIdx.x * blockDim.x + threadIdx.x;
    if (i < n) { float v = c[i]; o[i] = v / (1.f + expf(-v)); }
}
__global__ void k_mod(const float* __restrict__ cact, const float* __restrict__ W, const float* __restrict__ bias, float* __restrict__ out, int N) {
    __shared__ float cs[8 * 1024];
    for (int i = threadIdx.x; i < 8 * 1024; i += blockDim.x) cs[i] = cact[i];
    __syncthreads();
    int n = blockIdx.x * blockDim.x + threadIdx.x;
    if (n >= N) return;
    float acc[8];
#pragma unroll
    for (int b = 0; b < 8; ++b) acc[b] = 0.f;
    for (int k = 0; k < 1024; ++k) {
        float w = W[(size_t)k * N + n];
#pragma unroll
        for (int b = 0; b < 8; ++b) acc[b] += cs[b * 1024 + k] * w;
    }
#pragma unroll
    for (int b = 0; b < 8; ++b) out[(size_t)b * N + n] = acc[b] + bias[n];
}
__global__ void k_normmod(const float* x, const float* __restrict__ gain, const float* __restrict__ sh, const float* __restrict__ sc, int mstride, float* out) {
    __shared__ float red[4];
    const int m = blockIdx.x, b = m / SEQ, tid = threadIdx.x;
    const float4 v = ((const float4*)(x + (size_t)m * D_MODEL))[tid];
    float ss = v.x * v.x + v.y * v.y + v.z * v.z + v.w * v.w;
    for (int o = 32; o > 0; o >>= 1) ss += __shfl_xor(ss, o);
    if ((tid & 63) == 0) red[tid >> 6] = ss;
    __syncthreads();
    ss = red[0] + red[1] + red[2] + red[3];
    const float rstd = rsqrtf(ss * (1.f / D_MODEL) + RMS_EPS);
    const float4 g = ((const float4*)gain)[tid];
    const float4 s1 = ((const float4*)(sc + (size_t)b * mstride))[tid];
    const float4 s0 = ((const float4*)(sh + (size_t)b * mstride))[tid];
    float4 o;
    o.x = (v.x * rstd * g.x) * (1.f + s1.x) + s0.x;
    o.y = (v.y * rstd * g.y) * (1.f + s1.y) + s0.y;
    o.z = (v.z * rstd * g.z) * (1.f + s1.z) + s0.z;
    o.w = (v.w * rstd * g.w) * (1.f + s1.w) + s0.w;
    ((float4*)(out + (size_t)m * D_MODEL))[tid] = o;
}
template <int MODE>
__global__ void __launch_bounds__(256) k_gemm(const float* __restrict__ A, int lda, const float* __restrict__ W, const float* __restrict__ W2, int N, int K,
                                              float* C, int ldc, const float* R, const float* __restrict__ gate, int gstride) {
    __shared__ float As[16][64 + 4];
    __shared__ float Ws[16][64 + 4];
    __shared__ float W2s[MODE == 2 ? 16 : 1][64 + 4];
    const int tid = threadIdx.x, tx = tid & 15, ty = tid >> 4;
    const int m0 = blockIdx.y * 64, n0 = blockIdx.x * 64;
    float acc[4][4], acc2[4][4];
#pragma unroll
    for (int i = 0; i < 4; ++i)
#pragma unroll
        for (int j = 0; j < 4; ++j) { acc[i][j] = 0.f; acc2[i][j] = 0.f; }
    for (int k0 = 0; k0 < K; k0 += 16) {
        {
            const int r = tid >> 2, kq = (tid & 3) * 4;
            const float4 a = *(const float4*)(A + (size_t)(m0 + r) * lda + k0 + kq);
            As[kq + 0][r] = a.x; As[kq + 1][r] = a.y; As[kq + 2][r] = a.z; As[kq + 3][r] = a.w;
        }
        {
            const int kk = tid >> 4, nq = (tid & 15) * 4;
#pragma unroll
            for (int j = 0; j < 4; ++j) {
                const int n = n0 + nq + j;
                Ws[kk][nq + j] = (n < N) ? W[(size_t)(k0 + kk) * N + n] : 0.f;
                if (MODE == 2) W2s[kk][nq + j] = (n < N) ? W2[(size_t)(k0 + kk) * N + n] : 0.f;
            }
        }
        __syncthreads();
#pragma unroll
        for (int kk = 0; kk < 16; ++kk) {
            float a[4], w[4], w2[4];
#pragma unroll
            for (int i = 0; i < 4; ++i) a[i] = As[kk][ty * 4 + i];
#pragma unroll
            for (int j = 0; j < 4; ++j) { w[j] = Ws[kk][tx * 4 + j]; if (MODE == 2) w2[j] = W2s[kk][tx * 4 + j]; }
#pragma unroll
            for (int i = 0; i < 4; ++i)
#pragma unroll
                for (int j = 0; j < 4; ++j) { acc[i][j] += a[i] * w[j]; if (MODE == 2) acc2[i][j] += a[i] * w2[j]; }
        }
        __syncthreads();
    }
#pragma unroll
    for (int i = 0; i < 4; ++i) {
        const int m = m0 + ty * 4 + i, b = m / SEQ;
#pragma unroll
        for (int j = 0; j < 4; ++j) {
            const int n = n0 + tx * 4 + j;
            if (n < N) {
                float v = acc[i][j];
                if (MODE == 1) v = R[(size_t)m * ldc + n] + gate[(size_t)b * gstride + n] * v;
                if (MODE == 2) { const float gt = v; v = (gt / (1.f + expf(-gt))) * acc2[i][j]; }
                C[(size_t)m * ldc + n] = v;
            }
        }
    }
}
__global__ void k_kvdec(const float* __restrict__ proj, const float* __restrict__ kvg, const float* __restrict__ wuk, const float* __restrict__ wuv, float* __restrict__ kd, float* __restrict__ vd) {
    __shared__ float kvn[256];
    __shared__ float red[2];
    const int m = blockIdx.x, tid = threadIdx.x;
    const float* row = proj + (size_t)m * IN_COLS + C_KVL;
    const float a = row[tid], b = row[tid + 128];
    float ss = a * a + b * b;
    for (int o = 32; o > 0; o >>= 1) ss += __shfl_xor(ss, o);
    if ((tid & 63) == 0) red[tid >> 6] = ss;
    __syncthreads();
    const float rstd = rsqrtf((red[0] + red[1]) * (1.f / KV_LORA) + RMS_EPS);
    kvn[tid] = a * rstd * kvg[tid]; kvn[tid + 128] = b * rstd * kvg[tid + 128];
    __syncthreads();
    const float* w = (tid < 64) ? wuk : wuv; const int n = tid & 63;
    float acc = 0.f;
    for (int j = 0; j < 256; ++j) acc += kvn[j] * w[j * 64 + n];
    if (tid < 64) kd[(size_t)m * 64 + n] = acc; else vd[(size_t)m * 64 + n] = acc;
}
__global__ void __launch_bounds__(256) k_sb_attn(const float* __restrict__ proj, float* __restrict__ ocat) {
    __shared__ float qs[4][64];
    const int tid = threadIdx.x, lane = tid & 63, w = tid >> 6;
    const int wave = blockIdx.x * 4 + w;
    const int t = wave % SEQ, bh = wave / SEQ, h = bh % 8, b = bh / 8;
    const size_t mrow = (size_t)b * SEQ;
    qs[w][lane] = proj[(mrow + t) * IN_COLS + C_SBQ + h * 64 + lane];
    __syncthreads();
    float carry = 0.f, o = 0.f;
    for (int s_hi = t - 1; s_hi >= 0; s_hi -= 64) {
        const int s = s_hi - lane; const bool valid = s >= 0;
        float z = 0.f;
        if (valid) {
            const float4* kr = (const float4*)(proj + (mrow + s) * IN_COLS + C_SBK + h * 64);
            float d = 0.f;
#pragma unroll
            for (int i = 0; i < 16; ++i) { const float4 kv = kr[i]; d += qs[w][4 * i] * kv.x + qs[w][4 * i + 1] * kv.y + qs[w][4 * i + 2] * kv.z + qs[w][4 * i + 3] * kv.w; }
            z = d * 0.125f;
        }
        const float sp = fmaxf(z, 0.f) + log1pf(expf(-fabsf(z)));
        const float L = valid ? -sp : 0.f;
        float incl = L;
#pragma unroll
        for (int off = 1; off < 64; off <<= 1) { const float n = __shfl_up(incl, off); if (lane >= off) incl += n; }
        const float tail = carry + (incl - L);
        const float Aw = valid ? expf((z - sp) + tail) : 0.f;
        carry += __shfl(incl, 63);
        const int nvalid = (s_hi + 1 < 64) ? s_hi + 1 : 64;
        for (int j = 0; j < nvalid; ++j) {
            const float a = __shfl(Aw, j);
            o += a * proj[(mrow + (s_hi - j)) * IN_COLS + C_SBV + h * 64 + lane];
        }
    }
    ocat[(mrow + t) * D_MODEL + h * 64 + lane] = o;
}
__global__ void __launch_bounds__(256) k_idx(const float* __restrict__ proj, unsigned* __restrict__ mask) {
    __shared__ float qi[256];
    __shared__ float wi[4];
    __shared__ float score[SEQ];
    const int m = blockIdx.x, t = m % SEQ, b = m / SEQ, tid = threadIdx.x, lane = tid & 63;
    const size_t mrow = (size_t)b * SEQ;
    qi[tid] = proj[(size_t)m * IN_COLS + C_IQ + tid];
    if (tid < 4) wi[tid] = proj[(size_t)m * IN_COLS + C_IW + tid] * 0.5f;
    __syncthreads();
    const int n = t + 1;
    for (int s = tid; s < n; s += 256) {
        const float4* kr = (const float4*)(proj + (mrow + s) * IN_COLS + C_IK);
        float d[4] = {0.f, 0.f, 0.f, 0.f};
#pragma unroll
        for (int i = 0; i < 16; ++i) {
            const float4 kv = kr[i];
#pragma unroll
            for (int hh = 0; hh < 4; ++hh) d[hh] += qi[hh * 64 + 4 * i] * kv.x + qi[hh * 64 + 4 * i + 1] * kv.y + qi[hh * 64 + 4 * i + 2] * kv.z + qi[hh * 64 + 4 * i + 3] * kv.w;
        }
        float sc = 0.f;
#pragma unroll
        for (int hh = 0; hh < 4; ++hh) sc += fmaxf(d[hh] * 0.125f, 0.f) * wi[hh];
        score[s] = sc;
    }
    __syncthreads();
    for (int base = 0; base < SEQ; base += 256) {
        const int s = base + tid;
        bool sel = false;
        if (s < n) {
            if (n <= 256) sel = true;
            else {
                const float v = score[s]; int rank = 0;
                for (int j = 0; j < n; ++j) { const float u = score[j]; rank += (u > v || (u == v && j < s)) ? 1 : 0; }
                sel = rank < 256;
            }
        }
        const unsigned long long bal = __ballot(sel);
        if (lane == 0) { mask[(size_t)m * 64 + (s >> 5)] = (unsigned)bal; mask[(size_t)m * 64 + (s >> 5) + 1] = (unsigned)(bal >> 32); }
    }
}
__global__ void __launch_bounds__(256) k_dsa_attn(const float* __restrict__ proj, const float* __restrict__ kd, const float* __restrict__ vd, const unsigned* __restrict__ mask, float* __restrict__ ocat) {
    __shared__ float qs[4][64];
    const int tid = threadIdx.x, lane = tid & 63, w = tid >> 6;
    const int wave = blockIdx.x * 4 + w;
    const int h = wave % 8, m = wave / 8, t = m % SEQ, b = m / SEQ;
    const size_t mrow = (size_t)b * SEQ;
    qs[w][lane] = proj[(size_t)m * IN_COLS + C_DQ + h * 64 + lane] * 0.125f;
    __syncthreads();
    const float slope = exp2f(-(float)(h + 1));
    float mrun = -INFINITY, l = 0.f, o = 0.f;
    for (int s0 = 0; s0 <= t; s0 += 64) {
        const unsigned w0 = mask[(size_t)m * 64 + (s0 >> 5)], w1 = mask[(size_t)m * 64 + (s0 >> 5) + 1];
        const unsigned long long bits = ((unsigned long long)w1 << 32) | w0;
        if (bits == 0ull) continue;
        const int s = s0 + lane; const bool sel = (bits >> lane) & 1ull;
        float logit = -INFINITY;
        if (sel) {
            const float4* kr = (const float4*)(kd + (mrow + s) * 64);
            float d = 0.f;
#pragma unroll
            for (int i = 0; i < 16; ++i) { const float4 kv = kr[i]; d += qs[w][4 * i] * kv.x + qs[w][4 * i + 1] * kv.y + qs[w][4 * i + 2] * kv.z + qs[w][4 * i + 3] * kv.w; }
            logit = d - slope * (float)(t - s);
        }
        float cmax = logit;
        for (int off = 32; off > 0; off >>= 1) cmax = fmaxf(cmax, __shfl_xor(cmax, off));
        const float nm = fmaxf(mrun, cmax);
        const float alpha = expf(mrun - nm);
        const float p = sel ? expf(logit - nm) : 0.f;
        float ps = p;
        for (int off = 32; off > 0; off >>= 1) ps += __shfl_xor(ps, off);
        l = l * alpha + ps; o *= alpha; mrun = nm;
        for (int j = 0; j < 64; ++j) {
            if ((bits >> j) & 1ull) { const float pj = __shfl(p, j); o += pj * vd[(mrow + s0 + j) * 64 + lane]; }
        }
    }
    ocat[(size_t)m * D_MODEL + 512 + h * 64 + lane] = o / l;
}
__global__ void k_outnorm(float* ocat, const float* __restrict__ gsb, const float* __restrict__ gdsa) {
    __shared__ float red[4];
    const int m = blockIdx.x, tid = threadIdx.x;
    float4 v = ((float4*)(ocat + (size_t)m * D_MODEL))[tid];
    float ss = v.x * v.x + v.y * v.y + v.z * v.z + v.w * v.w;
    for (int o = 32; o > 0; o >>= 1) ss += __shfl_xor(ss, o);
    if ((tid & 63) == 0) red[tid >> 6] = ss;
    __syncthreads();
    const float tot = (tid < 128) ? (red[0] + red[1]) : (red[2] + red[3]);
    const float rstd = rsqrtf(tot * (1.f / 512.f) + RMS_EPS);
    const float4 g = (tid < 128) ? ((const float4*)gsb)[tid] : ((const float4*)gdsa)[tid - 128];
    v.x = v.x * rstd * g.x; v.y = v.y * rstd * g.y; v.z = v.z * rstd * g.z; v.w = v.w * rstd * g.w;
    ((float4*)(ocat + (size_t)m * D_MODEL))[tid] = v;
}
}

extern "C" void kernel_launch(void* const* d_in, const int* in_sizes, int n_in, void* d_out, int out_size, void* d_ws, size_t ws_size, hipStream_t stream) {
    const float* x = (const float*)d_in[0]; const float* c = (const float*)d_in[1];
    const float* w_mod = (const float*)d_in[2]; const float* b_mod = (const float*)d_in[3];
    const float* g1 = (const float*)d_in[4]; const float* g2 = (const float*)d_in[5];
    const float* w_in = (const float*)d_in[6]; const float* kvg = (const float*)d_in[7];
    const float* wuk = (const float*)d_in[8]; const float* wuv = (const float*)d_in[9];
    const float* gsb = (const float*)d_in[10]; const float* gdsa = (const float*)d_in[11];
    const float* w_o = (const float*)d_in[12]; const float* w_gate = (const float*)d_in[13];
    const float* w_up = (const float*)d_in[14]; const float* w_down = (const float*)d_in[15];
    const float* w_modf = (const float*)d_in[16]; const float* b_modf = (const float*)d_in[17]; const float* gfin = (const float*)d_in[18];
    float* out = (float*)d_out; char* ws = (char*)d_ws;
    float* mod0 = (float*)(ws + WS_MOD); float* mod1 = mod0 + 8 * 6144; float* modf = mod1 + 8 * 6144; float* cact = modf + 8 * 2048;
    float* H = (float*)(ws + WS_H); float* PROJ = (float*)(ws + WS_PROJ); float* KD = (float*)(ws + WS_KD); float* VD = (float*)(ws + WS_VD);
    unsigned* MASK = (unsigned*)(ws + WS_MASK);

    k_silu<<<32, 256, 0, stream>>>(c, cact, 8192);
    k_mod<<<6144 / 256, 256, 0, stream>>>(cact, w_mod, b_mod, mod0, 6144);
    k_mod<<<6144 / 256, 256, 0, stream>>>(cact, w_mod + (size_t)1024 * 6144, b_mod + 6144, mod1, 6144);
    k_mod<<<2048 / 256, 256, 0, stream>>>(cact, w_modf, b_modf, modf, 2048);
    for (int l = 0; l < DEPTH; ++l) {
        const float* mod = l ? mod1 : mod0;
        const float* xin = l ? out : x;
        k_normmod<<<M, 256, 0, stream>>>(xin, g1 + l * 1024, mod + 0, mod + 1024, 6144, H);
        k_gemm<0><<<dim3((IN_COLS + 63) / 64, M / 64), 256, 0, stream>>>(H, 1024, w_in + (size_t)l * 1024 * IN_COLS, nullptr, IN_COLS, 1024, PROJ, IN_COLS, nullptr, nullptr, 0);
        k_kvdec<<<M, 128, 0, stream>>>(PROJ, kvg + l * 256, wuk + l * 256 * 64, wuv + l * 256 * 64, KD, VD);
        k_sb_attn<<<BATCH * 8 * SEQ / 4, 256, 0, stream>>>(PROJ, H);
        k_idx<<<M, 256, 0, stream>>>(PROJ, MASK);
        k_dsa_attn<<<M * 8 / 4, 256, 0, stream>>>(PROJ, KD, VD, MASK, H);
        k_outnorm<<<M, 256, 0, stream>>>(H, gsb + l * 512, gdsa + l * 512);
        k_gemm<1><<<dim3(1024 / 64, M / 64), 256, 0, stream>>>(H, 1024, w_o + (size_t)l * 1024 * 1024, nullptr, 1024, 1024, out, 1024, xin, mod + 2048, 6144);
        k_normmod<<<M, 256, 0, stream>>>(out, g2 + l * 1024, mod + 3072, mod + 4096, 6144, H);
        k_gemm<2><<<dim3(D_FF / 64, M / 64), 256, 0, stream>>>(H, 1024, w_gate + (size_t)l * 1024 * D_FF, w_up + (size_t)l * 1024 * D_FF, D_FF, 1024, PROJ, D_FF, nullptr, nullptr, 0);
        k_gemm<1><<<dim3(1024 / 64, M / 64), 256, 0, stream>>>(PROJ, D_FF, w_down + (size_t)l * D_FF * 1024, nullptr, 1024, D_FF, out, 1024, out, mod + 5120, 6144);
    }
    k_normmod<<<M, 256, 0, stream>>>(out, gfin, modf + 0, modf + 1024, 2048, out);
}
```

```cpp
#include <hip/hip_runtime.h>
#include <cstdio>
#include <cstdint>
#include <cmath>
namespace pg8 {
#define PG8_LAS __attribute__((address_space(3)))
typedef unsigned short bf16_t;
typedef short bf16x8 __attribute__((ext_vector_type(8)));
typedef float f32x4 __attribute__((ext_vector_type(4)));
typedef unsigned u32x4 __attribute__((ext_vector_type(4)));
constexpr int BM = 256, BK = 64, HALF = 128, HTB = HALF * BK * 2  , STAGE_BYTES = 8 * HTB, NXCD = 8, WGM = 8;

__host__ __device__ __forceinline__ int lds_byte(int r, int c) { const int st = (r >> 4) * 2 + (c >> 5), rr = r & 15, cc = c & 31, ob = rr * 64 + cc * 2; return st * 1024 + (ob ^ (((ob >> 9) & 1) << 5)); }
__host__ __device__ __forceinline__ void stage_rc(int b, int& R, int& C) { const int st = b / 1024, sb = b % 1024, swz = sb ^ (((sb >> 9) & 1) << 5); R = (st >> 1) * 16 + swz / 64; C = (st & 1) * 32 + (swz % 64) / 2; }
__host__ __device__ __forceinline__ int perm32(int rho) { const int n = rho >> 4, i = rho & 15; return 8 * (i >> 2) + 4 * n + (i & 3); }

struct Unit { int pm, pn; };
struct Gemm { const bf16_t* A; const bf16_t* Bt; int M, N, K; };

struct StaticOrder {
    int nM, nN, nwg, G, c;
    __host__ __device__ void init(int M, int N, int G_, int c_) { nM = M / BM; nN = N / BM; nwg = nM * nN; G = G_; c = c_; }
    __host__ __device__ bool next(int i, Unit& u) const {
        const long L = (long)i * G + c; if (L >= nwg) return false;
        int wgid = (int)L; { const int q = nwg / NXCD, r = nwg % NXCD, xcd = wgid % NXCD, off = wgid / NXCD; wgid = (xcd < r ? xcd * (q + 1) : r * (q + 1) + (xcd - r) * q) + off; }
        const int nig = WGM * nN, gid = wgid / nig, fm = gid * WGM, gsz = (nM - fm) < WGM ? (nM - fm) : WGM;
        u.pm = fm + ((wgid % nig) % gsz); u.pn = (wgid % nig) / gsz; return true;
    }
    __device__ __forceinline__ void a_ready(const Unit&) const {}
    __device__ __forceinline__ void done(const Unit&) const {}
};

__device__ __forceinline__ unsigned cvt_pk_bf16(float lo, float hi) { unsigned r; asm volatile("v_cvt_pk_bf16_f32 %0, %1, %2" : "=v"(r) : "v"(lo), "v"(hi)); return r; }
typedef float f32x2 __attribute__((ext_vector_type(2)));
__device__ __forceinline__ float silu_f(float g) { return g * __builtin_amdgcn_rcpf(1.0f + __builtin_amdgcn_exp2f(-1.4426950408889634f * g)); }
struct EpiProj {
    static constexpr bool PERM = true, AFTER_DRAIN = false;
    bf16_t* O; int ldc; float qscale;
    __device__ __forceinline__ void operator()(const f32x4 (&acc)[2][2][4][2], const Unit& u, int wr, int wc, int fr, int fq) const {
        const int row0 = u.pm * BM + wr * 64 + fr, col0 = u.pn * BM + wc * 32 + 8 * fq;
        const float sc = (u.pn < 2 || u.pn == 6 || u.pn == 7) ? qscale : 1.0f;
#pragma unroll
        for (int ai = 0; ai < 2; ++ai)
#pragma unroll
            for (int m = 0; m < 4; ++m) { bf16_t* rowp = O + (size_t)(row0 + ai * HALF + m * 16) * ldc + col0;
#pragma unroll
                for (int bj = 0; bj < 2; ++bj) { const f32x4 v0 = acc[ai][bj][m][0] * sc, v1 = acc[ai][bj][m][1] * sc;
                    u32x4 w; w.x = cvt_pk_bf16(v0[0], v0[1]); w.y = cvt_pk_bf16(v0[2], v0[3]); w.z = cvt_pk_bf16(v1[0], v1[1]); w.w = cvt_pk_bf16(v1[2], v1[3]);
                    *(u32x4*)(rowp + bj * HALF) = w; } }
    }
};
struct EpiSwiGLU {
    static constexpr bool PERM = true, AFTER_DRAIN = false;
    bf16_t* Hb; int ldh;
    __device__ __forceinline__ void operator()(const f32x4 (&acc)[2][2][4][2], const Unit& u, int wr, int wc, int fr, int fq) const {
        const int row0 = u.pm * BM + wr * 64 + fr, col0 = u.pn * HALF + wc * 32 + 8 * fq;
#pragma unroll
        for (int ai = 0; ai < 2; ++ai)
#pragma unroll
            for (int m = 0; m < 4; ++m) { bf16_t* rowp = Hb + (size_t)(row0 + ai * HALF + m * 16) * ldh + col0;
                const f32x4 g0 = acc[ai][0][m][0], g1 = acc[ai][0][m][1], u0 = acc[ai][1][m][0], u1 = acc[ai][1][m][1];
                u32x4 w;
                w.x = cvt_pk_bf16(silu_f(g0[0]) * u0[0], silu_f(g0[1]) * u0[1]); w.y = cvt_pk_bf16(silu_f(g0[2]) * u0[2], silu_f(g0[3]) * u0[3]);
                w.z = cvt_pk_bf16(silu_f(g1[0]) * u1[0], silu_f(g1[1]) * u1[1]); w.w = cvt_pk_bf16(silu_f(g1[2]) * u1[2], silu_f(g1[3]) * u1[3]);
                *(u32x4*)rowp = w; }
    }
};
struct EpiResid {
    static constexpr bool PERM = false, AFTER_DRAIN = false;
    const float* R; float* out; int ldc; const float* gate; int gstride;
    __device__ __forceinline__ void operator()(const f32x4 (&acc)[2][2][4][2], const Unit& u, int wr, int wc, int fr, int fq) const {
        const int col0 = u.pn * BM + wc * 32 + 4 * fq; const float* gb = gate + (size_t)(u.pm >> 3) * gstride;
        f32x4 gv[2][2];
#pragma unroll
        for (int bj = 0; bj < 2; ++bj)
#pragma unroll
            for (int n = 0; n < 2; ++n) gv[bj][n] = *(const f32x4*)(gb + col0 + bj * HALF + n * 16);
#pragma unroll
        for (int ai = 0; ai < 2; ++ai)
#pragma unroll
            for (int m = 0; m < 4; ++m) { const size_t off = (size_t)(u.pm * BM + ai * HALF + wr * 64 + m * 16 + fr) * ldc + col0;
#pragma unroll
                for (int bj = 0; bj < 2; ++bj)
#pragma unroll
                    for (int n = 0; n < 2; ++n) { const f32x4 r = *(const f32x4*)(R + off + bj * HALF + n * 16); *(f32x4*)(out + off + bj * HALF + n * 16) = r + gv[bj][n] * acc[ai][bj][m][n]; } }
    }
};
template <class Epi, class Sched, bool ALIGN_EPI = false, bool SP2 = false>
__device__ __forceinline__ void gemm_phase(PG8_LAS unsigned char* lds, const Gemm g, const Sched& S, const Epi& E, const int tid) {
    const int wid = __builtin_amdgcn_readfirstlane(tid >> 6), lane = tid & 63, wr = wid >> 2, wc = wid & 3, fr = lane & 15, fq = lane >> 4;
    const int K = g.K, nt = K / BK;
    unsigned voffA[2], voffB[2];
#pragma unroll
    for (int i = 0; i < 2; ++i) { int R, C; stage_rc(tid * 16 + i * 8192, R, C); const int Rb = Epi::PERM ? ((R & ~31) + perm32(R & 31)) : R;
        voffA[i] = (unsigned)(R * K + C) * 2u; voffB[i] = (unsigned)(Rb * K + C) * 2u; }
    const size_t kstep = (size_t)(BK * 2);
    const size_t hstep = (size_t)HALF * K * 2;
    const size_t tstep = 2 * hstep;
    const unsigned ldsw = (unsigned)wid * 1024u;
    const int aoff = lds_byte(wr * 64 + fr, fq * 8), boff = lds_byte(wc * 32 + fr, fq * 8);
#define PG8_SA(b, h) (((b) * 2 + (h)) * HTB)
#define PG8_SB(b, h) ((4 + (b) * 2 + (h)) * HTB)
#define PG8_STAGE(bufoff, gbase, voff) do { _Pragma("unroll") for (int _i = 0; _i < 2; ++_i) \
        __builtin_amdgcn_global_load_lds((const unsigned*)((const char*)(gbase) + (voff)[_i]), (PG8_LAS unsigned*)(lds + (bufoff) + ldsw + _i * 8192), 16, 0, 0); } while (0)
#define PG8_LDA(dst, b, h) do { _Pragma("unroll") for (int m = 0; m < 4; ++m) _Pragma("unroll") for (int k = 0; k < 2; ++k) dst[m][k] = *(const PG8_LAS bf16x8*)(lds + PG8_SA(b, h) + aoff + m * 2048 + k * 1024); } while (0)
#define PG8_LDB(dst, b, h) do { _Pragma("unroll") for (int n = 0; n < 2; ++n) _Pragma("unroll") for (int k = 0; k < 2; ++k) dst[n][k] = *(const PG8_LAS bf16x8*)(lds + PG8_SB(b, h) + boff + n * 2048 + k * 1024); } while (0)
#define PG8_MMA(ai, bj, At, Bt) do { __builtin_amdgcn_s_setprio(1); _Pragma("unroll") for (int m = 0; m < 4; ++m) _Pragma("unroll") for (int n = 0; n < 2; ++n) _Pragma("unroll") for (int k = 0; k < 2; ++k) \
        acc[ai][bj][m][n] = __builtin_amdgcn_mfma_f32_16x16x32_bf16(Bt[n][k], At[m][k], acc[ai][bj][m][n], 0, 0, 0); __builtin_amdgcn_s_setprio(0); } while (0)
#define PG8_WAIT_V(n) asm volatile("s_waitcnt vmcnt(" #n ")" ::: "memory")
#define PG8_WAIT_L(n) asm volatile("s_waitcnt lgkmcnt(" #n ")" ::: "memory")
#define PG8_BAR __builtin_amdgcn_s_barrier()
#define PG8_SCHED __builtin_amdgcn_sched_barrier(0)
    Unit cur, nxt; int ui = 0;
    if (!S.next(0, cur)) return;
    f32x4 acc[2][2][4][2];
#pragma unroll
    for (int a = 0; a < 2; ++a)
#pragma unroll
        for (int b = 0; b < 2; ++b)
#pragma unroll
            for (int m = 0; m < 4; ++m)
#pragma unroll
                for (int n = 0; n < 2; ++n) acc[a][b][m][n] = (f32x4){0.f, 0.f, 0.f, 0.f};
    bf16x8 At[4][2], B0[2][2], B1[2][2];
    const char* cA = (const char*)g.A + (size_t)cur.pm * tstep; const char* cB = (const char*)g.Bt + (size_t)cur.pn * tstep;
    S.a_ready(cur);
    if constexpr (SP2) {
        PG8_STAGE(PG8_SB(0, 0), cB, voffB); PG8_STAGE(PG8_SB(0, 1), cB + hstep, voffB); PG8_STAGE(PG8_SA(0, 0), cA, voffA); PG8_STAGE(PG8_SA(0, 1), cA + hstep, voffA);
        if (wr == 1) PG8_BAR;
        PG8_WAIT_V(2); PG8_BAR;
        PG8_STAGE(PG8_SB(1, 0), cB + kstep, voffB); PG8_STAGE(PG8_SA(1, 0), cA + kstep, voffA); PG8_STAGE(PG8_SB(1, 1), cB + hstep + kstep, voffB);
        PG8_WAIT_V(6); PG8_BAR;
    } else {
        PG8_STAGE(PG8_SB(0, 0), cB, voffB); PG8_STAGE(PG8_SA(0, 0), cA, voffA); PG8_STAGE(PG8_SB(0, 1), cB + hstep, voffB); PG8_STAGE(PG8_SA(0, 1), cA + hstep, voffA);
        if (wr == 1) PG8_BAR;
        PG8_WAIT_V(4); PG8_BAR;
        PG8_STAGE(PG8_SB(1, 0), cB + kstep, voffB); PG8_STAGE(PG8_SA(1, 0), cA + kstep, voffA); PG8_STAGE(PG8_SB(1, 1), cB + hstep + kstep, voffB);
        PG8_WAIT_V(6); PG8_BAR;
    }
    for (;;) {
        const bool has_next = S.next(ui + 1, nxt);
        const char* nA = has_next ? (const char*)g.A + (size_t)nxt.pm * tstep : cA; const char* nB = has_next ? (const char*)g.Bt + (size_t)nxt.pn * tstep : cB;
        for (int t = 0; t < nt; t += 2) {
            const bool last = (t == nt - 2);
            const char* a1 = cA + (size_t)(t + 1) * kstep;
            const char* a2 = last ? nA : cA + (size_t)(t + 2) * kstep; const char* b2 = last ? nB : cB + (size_t)(t + 2) * kstep;
            const char* a3 = a2 + kstep; const char* b3 = b2 + kstep;
            if (last && has_next) S.a_ready(nxt);
            if constexpr (SP2) {
            PG8_LDB(B0, 0, 0); PG8_LDB(B1, 0, 1); PG8_SCHED; PG8_LDA(At, 0, 0); PG8_STAGE(PG8_SA(1, 1), a1 + hstep, voffA);
            PG8_WAIT_V(8); PG8_WAIT_L(0); PG8_BAR; PG8_MMA(0, 0, At, B0); PG8_MMA(0, 1, At, B1); PG8_BAR; PG8_SCHED;
            PG8_LDA(At, 0, 1); PG8_STAGE(PG8_SB(0, 0), b2, voffB); PG8_STAGE(PG8_SB(0, 1), b2 + hstep, voffB); PG8_STAGE(PG8_SA(0, 0), a2, voffA);
            PG8_WAIT_V(8); PG8_WAIT_L(0); PG8_BAR; PG8_MMA(1, 0, At, B0); PG8_MMA(1, 1, At, B1); PG8_BAR; PG8_SCHED;
            PG8_LDB(B0, 1, 0); PG8_LDB(B1, 1, 1); PG8_SCHED; PG8_LDA(At, 1, 0); PG8_STAGE(PG8_SA(0, 1), a2 + hstep, voffA);
            PG8_WAIT_V(8); PG8_WAIT_L(0); PG8_BAR; PG8_MMA(0, 0, At, B0); PG8_MMA(0, 1, At, B1); PG8_BAR; PG8_SCHED;
            PG8_LDA(At, 1, 1); PG8_STAGE(PG8_SB(1, 0), b3, voffB); PG8_STAGE(PG8_SB(1, 1), b3 + hstep, voffB); PG8_STAGE(PG8_SA(1, 0), a3, voffA);
            PG8_WAIT_V(8); PG8_WAIT_L(0); PG8_BAR; PG8_MMA(1, 0, At, B0); PG8_MMA(1, 1, At, B1); PG8_BAR; PG8_SCHED;
            } else {
            PG8_LDB(B0, 0, 0); PG8_SCHED; PG8_LDA(At, 0, 0); PG8_STAGE(PG8_SA(1, 1), a1 + hstep, voffA);
            PG8_WAIT_L(8); PG8_BAR; PG8_WAIT_L(0); PG8_MMA(0, 0, At, B0); PG8_BAR; PG8_SCHED;
            PG8_LDB(B1, 0, 1); PG8_STAGE(PG8_SB(0, 0), b2, voffB);
            PG8_BAR; PG8_WAIT_L(0); PG8_MMA(0, 1, At, B1); PG8_BAR;
            PG8_LDA(At, 0, 1); PG8_STAGE(PG8_SA(0, 0), a2, voffA);
            PG8_BAR; PG8_WAIT_L(0); PG8_MMA(1, 0, At, B0); PG8_BAR; PG8_SCHED;
            PG8_STAGE(PG8_SB(0, 1), b2 + hstep, voffB);
            PG8_WAIT_V(6); PG8_BAR; PG8_MMA(1, 1, At, B1); PG8_BAR;
            PG8_LDB(B0, 1, 0); PG8_SCHED; PG8_LDA(At, 1, 0); PG8_STAGE(PG8_SA(0, 1), a2 + hstep, voffA);
            PG8_WAIT_L(8); PG8_BAR; PG8_WAIT_L(0); PG8_MMA(0, 0, At, B0); PG8_BAR; PG8_SCHED;
            PG8_LDB(B1, 1, 1); PG8_STAGE(PG8_SB(1, 0), b3, voffB);
            PG8_BAR; PG8_WAIT_L(0); PG8_MMA(0, 1, At, B1); PG8_BAR;
            PG8_LDA(At, 1, 1); PG8_STAGE(PG8_SA(1, 0), a3, voffA);
            PG8_BAR; PG8_WAIT_L(0); PG8_MMA(1, 0, At, B0); PG8_BAR; PG8_SCHED;
            PG8_STAGE(PG8_SB(1, 1), b3 + hstep, voffB);
            PG8_WAIT_V(6); PG8_BAR; PG8_MMA(1, 1, At, B1); PG8_BAR;
            }
        }
        if constexpr (ALIGN_EPI) { if (wr == 0) PG8_BAR; }
        if constexpr (!Epi::AFTER_DRAIN) { E(acc, cur, wr, wc, fr, fq); S.done(cur); }
        if (!has_next) break;
#pragma unroll
        for (int a = 0; a < 2; ++a)
#pragma unroll
            for (int b = 0; b < 2; ++b)
#pragma unroll
                for (int m = 0; m < 4; ++m)
#pragma unroll
                    for (int n = 0; n < 2; ++n) acc[a][b][m][n] = (f32x4){0.f, 0.f, 0.f, 0.f};
        cur = nxt; cA = nA; cB = nB; ++ui;
        if constexpr (ALIGN_EPI) { if (wr == 1) PG8_BAR; }
    }
    PG8_WAIT_V(0);
    if constexpr (!ALIGN_EPI) { if (wr == 0) PG8_BAR; }
    PG8_BAR;
    if constexpr (Epi::AFTER_DRAIN) { E.fused(acc, cur, wr, wc, fr, fq, lds, wid, lane); S.done(cur); }
#undef PG8_SA
#undef PG8_SB
#undef PG8_STAGE
#undef PG8_LDA
#undef PG8_LDB
#undef PG8_MMA
#undef PG8_WAIT_V
#undef PG8_WAIT_L
#undef PG8_BAR
#undef PG8_SCHED
}
}

#define GAS __attribute__((address_space(1)))
#define LAS __attribute__((address_space(3)))
typedef unsigned short bf16;
typedef unsigned v4u __attribute__((ext_vector_type(4)));
typedef float f32x4 __attribute__((ext_vector_type(4)));
typedef short bf16x8 __attribute__((ext_vector_type(8)));
typedef GAS unsigned gu32;
typedef GAS unsigned long long gu64;
#define RLX_AGENT __ATOMIC_RELAXED, __HIP_MEMORY_SCOPE_AGENT
#define LDS_WAIT() asm volatile("s_waitcnt lgkmcnt(0)" ::: "memory")
#define VM_WAIT() asm volatile("s_waitcnt vmcnt(0)" ::: "memory")
__device__ __forceinline__ unsigned long long rt() { return __builtin_amdgcn_s_memrealtime(); }
__device__ __forceinline__ unsigned f2bf(float f) { unsigned u = __builtin_bit_cast(unsigned, f); return (u + 0x7fffu + ((u >> 16) & 1u)) >> 16; }
__device__ __forceinline__ unsigned pk2(float lo, float hi) { return f2bf(lo) | (f2bf(hi) << 16); }

#define XB_TMO      128
#define XB_XCNT(j)  (256  + 64 * (j))
#define XB_XSUB(j)  (1280 + 64 * (j))
#define XB_XGEN(j)  (2304 + 64 * (j))
#define XB_TOP      3328
#define XB_TOPGEN   3392
#define XCD_BAR_WORDS 3456
#define XB_SPIN_CAP (1u << 18)

__device__ __forceinline__ unsigned xb_ld(unsigned* p)              { return __hip_atomic_load(p, __ATOMIC_RELAXED, __HIP_MEMORY_SCOPE_AGENT); }
__device__ __forceinline__ unsigned xb_add(unsigned* p, unsigned v) { return __hip_atomic_fetch_add(p, v, __ATOMIC_RELAXED, __HIP_MEMORY_SCOPE_AGENT); }
__device__ __forceinline__ unsigned xb_xcc_id() { return (unsigned)__builtin_amdgcn_s_getreg((3 << 11) | 20) & 0xFu; }
#define XB_SPIN(cond, bar) do { unsigned _sp = 0; while (cond) { __builtin_amdgcn_s_sleep(1); \
    if ((++_sp & 255u) == 0u) { if (xb_ld(&(bar)[XB_TMO])) break; if (_sp > XB_SPIN_CAP) { atomicAdd(&(bar)[XB_TMO], 1u); break; } } } } while (0)

struct XcdBarrier {
    unsigned* bar; unsigned x;
    volatile LAS unsigned* st;
};

__device__ __forceinline__ XcdBarrier xcd_barrier_post(unsigned* bar, volatile LAS unsigned* st) {
    XcdBarrier b; b.bar = bar; b.x = xb_xcc_id(); b.st = st;
    if (threadIdx.x == 0) (void)xb_add(&bar[XB_XCNT(b.x)], 1u);
    return b;
}
__device__ __forceinline__ void xcd_barrier_complete(unsigned* bar, unsigned x, unsigned& nloc, unsigned& nx) {
    const unsigned G = gridDim.x * gridDim.y * gridDim.z;
    unsigned sum, cnt, mine, sp = 0u;
    for (;;) {
        sum = 0u; cnt = 0u; mine = 0u;
#pragma unroll
        for (unsigned j = 0; j < 16; ++j) { const unsigned c = xb_ld(&bar[XB_XCNT(j)]); sum += c; cnt += (c > 0u) ? 1u : 0u; mine = (j == x) ? c : mine; }
        if (sum == G) break;
        __builtin_amdgcn_s_sleep(1);
        if ((++sp & 255u) == 0u) { if (xb_ld(&bar[XB_TMO])) break; if (sp > XB_SPIN_CAP) { atomicAdd(&bar[XB_TMO], 1u); break; } }
    }
    nloc = mine > 0u ? mine : 1u; nx = cnt > 0u ? cnt : 1u;
}

__device__ __forceinline__ void xcd_barrier(const XcdBarrier& b) {
    asm volatile("s_waitcnt vmcnt(0)" ::: "memory");
    __syncthreads();
    if (threadIdx.x == 0) {
        unsigned* bar = b.bar;
        __builtin_amdgcn_s_waitcnt(0);
        unsigned nloc = b.st[0], nx = b.st[1];
        if (nloc == 0u) { xcd_barrier_complete(bar, b.x, nloc, nx); b.st[0] = nloc; b.st[1] = nx; }
        const unsigned old = xb_add(&bar[XB_XSUB(b.x)], 1u);
        const unsigned gen = old / nloc;
        if (old + 1u == (gen + 1u) * nloc) {
            __builtin_amdgcn_fence(__ATOMIC_RELEASE, "agent");
            asm volatile("s_waitcnt vmcnt(0)" ::: "memory");
            const unsigned og = xb_add(&bar[XB_TOP], 1u);
            const unsigned tg = og / nx;
            if (og + 1u == (tg + 1u) * nx) xb_add(&bar[XB_TOPGEN], 1u);
            else XB_SPIN(xb_ld(&bar[XB_TOPGEN]) == tg, bar);
            __builtin_amdgcn_fence(__ATOMIC_ACQUIRE, "agent");
            xb_add(&bar[XB_XGEN(b.x)], 1u);
            asm volatile("s_waitcnt vmcnt(0)" ::: "memory");
        } else {
            XB_SPIN(xb_ld(&bar[XB_XGEN(b.x)]) == gen, bar);
            __builtin_amdgcn_fence(__ATOMIC_ACQUIRE, "agent");
            asm volatile("s_waitcnt vmcnt(0)" ::: "memory");
        }
    }
    __syncthreads();
}

constexpr int NWAVES = 8;
constexpr int D_MODEL = 1024, BATCH = 8, SEQ = 2048, DEPTH = 2, M = BATCH * SEQ;
constexpr int IN_COLS = 2628, NPROJ = 2816, D_FF = 2816, NGU = 2 * D_FF, KV_LORA = 256;
constexpr int C_SBQ = 0, C_SBK = 512, C_SBV = 1024, C_DQ = 1536, C_KVL = 2048, C_IQ = 2304, C_IK = 2560, C_IW = 2624;
constexpr float RMS_EPS = 1e-6f;
constexpr float LOG2E = 1.4426950408889634f;
constexpr float C2 = 0.125f * LOG2E;
constexpr size_t MiB = 1u << 20;
constexpr size_t WS_CTL = 0, CTL_ZERO_BYTES = 1 * MiB;
constexpr size_t WS_MOD = 1 * MiB;
constexpr size_t WS_WKV = 1 * MiB + 512 * 1024;
constexpr size_t WS_WIN = 2 * MiB, WIN_BYTES = (size_t)NPROJ * 1024 * 2;
constexpr size_t WS_WO = 13 * MiB, WO_BYTES = (size_t)1024 * 1024 * 2;
constexpr size_t WS_WGU = 17 * MiB, WGU_BYTES = (size_t)NGU * 1024 * 2;
constexpr size_t WS_WD = 39 * MiB, WD_BYTES = (size_t)1024 * D_FF * 2;
constexpr size_t WS_XN = 50 * MiB;
constexpr size_t WS_PROJ = 82 * MiB;
constexpr size_t WS_OSB = 170 * MiB;
constexpr size_t WS_OCAT = 186 * MiB;
constexpr size_t WS_KD = 218 * MiB, WS_VD = 220 * MiB;
constexpr size_t WS_MASK = 222 * MiB;
constexpr size_t WS_ODSA = 226 * MiB;
constexpr size_t WS_END = 242 * MiB;
constexpr int CW_BAR = 4096;
constexpr int RING_OFF = 0, RING_BYTES = 131072;
constexpr int LDSCTL_OFF = RING_BYTES, MISC_OFF = LDSCTL_OFF + 320;
constexpr int LDS_BYTES = 147456;
enum { PH_PRO = 0, PH_L0 = 1, SP_NORM1 = 0, SP_INPROJ = 1, SP_MIX1 = 2, SP_MIX2 = 3, SP_OUTPROJ = 4, SP_NORM2 = 5, SP_GATEUP = 6, SP_DOWN = 7, NSP = 8, PH_FINAL = PH_L0 + DEPTH * NSP, NPHASE = PH_FINAL + 1 };

struct Args { const float* in[19]; float* out; unsigned char* ws; int ph_lo, ph_hi; };

__device__ __forceinline__ float wave_sum(float v) {
#pragma unroll
    for (int o = 1; o < 64; o <<= 1) v += __shfl_xor(v, o);
    return v;
}
__device__ __forceinline__ float bf2f(unsigned short u) { return __uint_as_float((unsigned)u << 16); }

template <class RowMap>
__device__ __forceinline__ void transpose_item(const float* W, int K, int N, bf16* WT, LAS float* scr, int kb, int nb, int lane, RowMap rowmap) {
    const int k0 = 64 * kb, n0 = 32 * nb, nn = n0 + (lane & 31);
#pragma unroll 8
    for (int i = 0; i < 32; ++i) { const int kk = 2 * i + (lane >> 5); scr[kk * 33 + (lane & 31)] = (nn < N) ? W[(size_t)(k0 + kk) * N + nn] : 0.f; }
    LDS_WAIT(); asm volatile("" ::: "memory");
    const int c = lane & 7;
#pragma unroll
    for (int j = 0; j < 4; ++j) { const int n = (lane >> 3) + 8 * j; const LAS float* s = scr + (8 * c) * 33 + n;
        v4u o; o.x = pk2(s[0 * 33], s[1 * 33]); o.y = pk2(s[2 * 33], s[3 * 33]); o.z = pk2(s[4 * 33], s[5 * 33]); o.w = pk2(s[6 * 33], s[7 * 33]);
        *(GAS v4u*)(WT + (size_t)rowmap(n0 + n) * K + k0 + 8 * c) = o; }
    LDS_WAIT(); asm volatile("" ::: "memory");
}
struct RowId { __device__ __forceinline__ int operator()(int n) const { return n; } };
struct RowGU { int up; __device__ __forceinline__ int operator()(int n) const { return (n >> 7) * 256 + up * 128 + (n & 127); } };

__device__ __forceinline__ void normmod_row_bf16(const float* xrow, const float* gain, const float* sh, const float* sc, bf16* orow, int lane) {
    const GAS f32x4* xr = (const GAS f32x4*)xrow + lane;
    f32x4 v[4]; float s = 0.f;
#pragma unroll
    for (int j = 0; j < 4; ++j) { v[j] = xr[64 * j]; s += (v[j].x * v[j].x + v[j].y * v[j].y) + (v[j].z * v[j].z + v[j].w * v[j].w); }
    const float rstd = rsqrtf(wave_sum(s) * (1.f / D_MODEL) + RMS_EPS);
    GAS unsigned long long* o8 = (GAS unsigned long long*)orow + lane;
#pragma unroll
    for (int j = 0; j < 4; ++j) {
        const f32x4 g = ((const GAS f32x4*)gain)[64 * j + lane], a = ((const GAS f32x4*)sc)[64 * j + lane], b = ((const GAS f32x4*)sh)[64 * j + lane];
        const f32x4 y = (v[j] * rstd * g) * (a + 1.0f) + b;
        o8[64 * j] = (unsigned long long)pk2(y.x, y.y) | ((unsigned long long)pk2(y.z, y.w) << 32);
    }
}
__device__ __forceinline__ void normmod_row_f32(const float* xrow, const float* gain, const float* sh, const float* sc, float* orow, int lane) {
    const GAS f32x4* xr = (const GAS f32x4*)xrow + lane;
    f32x4 v[4]; float s = 0.f;
#pragma unroll
    for (int j = 0; j < 4; ++j) { v[j] = xr[64 * j]; s += (v[j].x * v[j].x + v[j].y * v[j].y) + (v[j].z * v[j].z + v[j].w * v[j].w); }
    const float rstd = rsqrtf(wave_sum(s) * (1.f / D_MODEL) + RMS_EPS);
#pragma unroll
    for (int j = 0; j < 4; ++j) {
        const f32x4 g = ((const GAS f32x4*)gain)[64 * j + lane], a = ((const GAS f32x4*)sc)[64 * j + lane], b = ((const GAS f32x4*)sh)[64 * j + lane];
        ((GAS f32x4*)orow)[64 * j + lane] = (v[j] * rstd * g) * (a + 1.0f) + b;
    }
}

namespace att {
using bf16x8 = __attribute__((ext_vector_type(8))) short;
using s16x4 = __attribute__((ext_vector_type(4))) short;
using f32x16 = __attribute__((ext_vector_type(16))) float;
using u32x4 = __attribute__((ext_vector_type(4))) unsigned;
typedef __attribute__((address_space(3))) const char* lds_cptr;
typedef short v4i16_t __attribute__((ext_vector_type(4)));
typedef float f32x2_t __attribute__((ext_vector_type(2))); typedef __bf16 bf16x2_t __attribute__((ext_vector_type(2)));
constexpr int PITCH = NPROJ;
constexpr int NSLOT = 3, SLOTB = 16384, VOFF = 8192;
constexpr int LDS_OST = NSLOT * SLOTB;
constexpr int LDS_SB_BYTES = LDS_OST + 8 * 4096;
__device__ __forceinline__ int crow(int r, int hi) { return (r & 3) + 8 * (r >> 2) + 4 * hi; }
__device__ __forceinline__ void glds16(const void* gsrc, unsigned lds_dst) { unsigned keep;
    asm volatile("s_mov_b32 %0, m0\n\ts_mov_b32 m0, %2\n\ts_nop 0\n\tglobal_load_lds_dwordx4 %1, off\n\ts_mov_b32 m0, %0" : "=&s"(keep) : "v"(gsrc), "s"(lds_dst) : "memory"); }
__device__ __forceinline__ unsigned cvtpk(float lo, float hi) { f32x2_t v = {lo, hi}; bf16x2_t b = __builtin_convertvector(v, bf16x2_t); return __builtin_bit_cast(unsigned, b); }
__device__ __forceinline__ s16x4 vtr(lds_cptr p) { return __builtin_bit_cast(s16x4, __builtin_amdgcn_ds_read_tr16_b64_v4i16((__attribute__((address_space(3))) v4i16_t*)p)); }
#define ATT_WAIT_BAR(N) asm volatile("s_waitcnt vmcnt(" #N ") lgkmcnt(0)\n\ts_barrier" ::: "memory")

template <bool DIAG>
__device__ __forceinline__ void sb_tile(lds_cptr kp, lds_cptr vp, const bf16x8 (&qr)[4], f32x16 (&o)[2], float& carry, int dd, float f0) {
    f32x16 y[2];
#pragma unroll
    for (int d0 = 0; d0 < 4; ++d0) {
        const bf16x8 b0 = *(const __attribute__((address_space(3))) bf16x8*)(kp + d0 * 2048);
        const bf16x8 b1 = *(const __attribute__((address_space(3))) bf16x8*)(kp + d0 * 2048 + 512);
        if (d0 == 0) { const f32x16 z = {}; y[0] = __builtin_amdgcn_mfma_f32_32x32x16_bf16(b0, qr[0], z, 0, 0, 0); y[1] = __builtin_amdgcn_mfma_f32_32x32x16_bf16(b1, qr[0], z, 0, 0, 0); }
        else { y[0] = __builtin_amdgcn_mfma_f32_32x32x16_bf16(b0, qr[d0], y[0], 0, 0, 0); y[1] = __builtin_amdgcn_mfma_f32_32x32x16_bf16(b1, qr[d0], y[1], 0, 0, 0); }
    }
    f32x16 x[2];
#pragma unroll
    for (int p = 0; p < 2; ++p)
#pragma unroll
        for (int r = 0; r < 16; ++r) {
            float lg = __builtin_amdgcn_logf(1.0f + __builtin_amdgcn_exp2f(y[p][r]));
            if (DIAG) lg = (32 * p + (r & 3) + 8 * (r >> 2) < dd) ? lg : 0.f;
            x[p][r] = lg;
        }
#pragma unroll
    for (int p = 0; p < 2; ++p)
#pragma unroll
        for (int g = 0; g < 4; ++g) { x[p][4 * g + 2] += x[p][4 * g + 3]; x[p][4 * g + 1] += x[p][4 * g + 2]; x[p][4 * g] += x[p][4 * g + 1]; }
    float R = carry;
    u32x4 pw[4];
#pragma unroll
    for (int p = 1; p >= 0; --p)
#pragma unroll
        for (int g = 3; g >= 0; --g) {
            const float T = x[p][4 * g];
            const auto rr = __builtin_amdgcn_permlane32_swap(__float_as_uint(T), __float_as_uint(T), false, false);
            const float Tlo = __uint_as_float(rr[0]), Thi = __uint_as_float(rr[1]);
            const float off = __builtin_fmaf(Thi, f0, R);
            R += Tlo + Thi;
            float a[4];
#pragma unroll
            for (int i = 0; i < 4; ++i) {
                a[i] = __builtin_amdgcn_exp2f((y[p][4 * g + i] - x[p][4 * g + i]) - off);
                if (DIAG) a[i] = (32 * p + i + 8 * g < dd) ? a[i] : 0.f;
            }
            pw[2 * p + (g >> 1)][(g & 1) * 2 + 0] = cvtpk(a[0], a[1]);
            pw[2 * p + (g >> 1)][(g & 1) * 2 + 1] = cvtpk(a[2], a[3]);
        }
    carry = R;
#pragma unroll
    for (int d0 = 0; d0 < 2; ++d0)
#pragma unroll
        for (int ks = 0; ks < 4; ++ks) {
            const s16x4 lo = vtr(vp + d0 * 4096 + ks * 1024), hi4 = vtr(vp + d0 * 4096 + ks * 1024 + 512);
            const bf16x8 vf = {lo[0], lo[1], lo[2], lo[3], hi4[0], hi4[1], hi4[2], hi4[3]};
            o[d0] = __builtin_amdgcn_mfma_f32_32x32x16_bf16(__builtin_bit_cast(bf16x8, pw[ks]), vf, o[d0], 0, 0, 0);
        }
}

__device__ __forceinline__ void sb_unit(int b, int h, int qb, const bf16* PROJ, bf16* OSB, LAS unsigned char* shm, int tid) {
    const int lane = tid & 63, r32 = lane & 31, hi = lane >> 5; const int wid = __builtin_amdgcn_readfirstlane(tid >> 6);
    const long rowbase = (long)b * SEQ; const int t0w = qb * 256 + wid * 32;
    const bf16* Qw = PROJ + (rowbase + t0w) * PITCH + C_SBQ + h * 64;
    const bf16* Kh = PROJ + rowbase * PITCH + C_SBK + h * 64; const bf16* Vh = PROJ + rowbase * PITCH + C_SBV + h * 64;
    const unsigned lds0 = (unsigned)(unsigned long)shm;
    const bf16* ksrc = Kh + (long)lane * PITCH + wid * 8;
    const bf16* vsrc = Vh + (long)(16 * (wid & 3) + (lane >> 2)) * PITCH + (wid >> 2) * 32 + (lane & 3) * 8;
    const unsigned kdst = lds0 + wid * 1024, vdst = lds0 + VOFF + wid * 1024;
#define SB_DMA(t, slot) do { glds16(ksrc + (long)(t) * 64 * PITCH, (unsigned)__builtin_amdgcn_readfirstlane(kdst + (slot) * SLOTB)); \
                             glds16(vsrc + (long)(t) * 64 * PITCH, (unsigned)__builtin_amdgcn_readfirstlane(vdst + (slot) * SLOTB)); } while (0)
    const lds_cptr shm3 = (lds_cptr)shm;
    const lds_cptr kp0 = shm3 + hi * 1024 + r32 * 16;
    const lds_cptr vp0 = shm3 + VOFF + ((lane >> 4) & 1) * 32 + (lane & 3) * 8 + (4 * hi + ((lane & 15) >> 2)) * 64;
    const int NT = 4 * (qb + 1), jdiag = (8 * qb + wid) >> 1;
    SB_DMA(NT - 1, 0);
    bf16x8 qr[4];
#pragma unroll
    for (int d0 = 0; d0 < 4; ++d0) qr[d0] = *reinterpret_cast<const bf16x8*>(&Qw[(long)r32 * PITCH + d0 * 16 + hi * 8]);
    f32x16 o[2]; o[0] = f32x16{}; o[1] = f32x16{};
    float carry = 0.f; const float f0 = hi ? 0.f : 1.f; const int dd = 32 * (wid & 1) + r32 - 4 * hi;
    int slot = 0;
    for (int it = 0; it < NT; ++it) {
        const int jt = NT - 1 - it; const int nslot = (slot == NSLOT - 1) ? 0 : slot + 1;
        if (it + 1 < NT) { SB_DMA(jt - 1, nslot); ATT_WAIT_BAR(2); } else { ATT_WAIT_BAR(0); }
        if (jt == jdiag) sb_tile<true>(kp0 + slot * SLOTB, vp0 + slot * SLOTB, qr, o, carry, dd, f0);
        else if (jt < jdiag) sb_tile<false>(kp0 + slot * SLOTB, vp0 + slot * SLOTB, qr, o, carry, dd, f0);
        slot = nslot;
    }
#undef SB_DMA
    {   LAS unsigned short* stg = (LAS unsigned short*)(shm + LDS_OST + wid * 4096);
#pragma unroll
        for (int r = 0; r < 16; ++r) { const int orow = crow(r, hi);
#pragma unroll
            for (int d0 = 0; d0 < 2; ++d0) stg[orow * 64 + d0 * 32 + r32] = (unsigned short)f2bf(o[d0][r]); }
        asm volatile("s_waitcnt lgkmcnt(0)" ::: "memory");
        bf16* Ow = OSB + (rowbase + t0w) * 512 + h * 64;
#pragma unroll
        for (int i = 0; i < 4; ++i) { const int row = i * 8 + (lane >> 3), ch = lane & 7; const u32x4 v = *(const LAS u32x4*)(stg + row * 64 + ch * 8); *(u32x4*)(Ow + (long)row * 512 + ch * 8) = v; }
    }
    asm volatile("s_waitcnt lgkmcnt(0)\n\ts_barrier" ::: "memory");
}
}

namespace idx {
using att::bf16x8; using att::f32x16;
constexpr int PITCH = NPROJ;
#define IDX_DPP(v, ctrl) __builtin_amdgcn_update_dpp(0, (v), (ctrl), 0xF, 0xF, true)
__device__ __forceinline__ int wave_sum_i(int v) {
    v += IDX_DPP(v, 0xB1); v += IDX_DPP(v, 0x4E); v += IDX_DPP(v, 0x141); v += IDX_DPP(v, 0x140);
    return __builtin_amdgcn_readlane(v, 0) + __builtin_amdgcn_readlane(v, 16) + __builtin_amdgcn_readlane(v, 32) + __builtin_amdgcn_readlane(v, 48);
}
__device__ __forceinline__ unsigned umax_(unsigned a, unsigned b) { return a > b ? a : b; }
__device__ __forceinline__ unsigned umin_(unsigned a, unsigned b) { return a < b ? a : b; }
__device__ __forceinline__ unsigned wave_max_u(unsigned v) {
    v = umax_(v, (unsigned)IDX_DPP((int)v, 0xB1)); v = umax_(v, (unsigned)IDX_DPP((int)v, 0x4E)); v = umax_(v, (unsigned)IDX_DPP((int)v, 0x141)); v = umax_(v, (unsigned)IDX_DPP((int)v, 0x140));
    return umax_(umax_((unsigned)__builtin_amdgcn_readlane((int)v, 0), (unsigned)__builtin_amdgcn_readlane((int)v, 16)), umax_((unsigned)__builtin_amdgcn_readlane((int)v, 32), (unsigned)__builtin_amdgcn_readlane((int)v, 48)));
}
__device__ __forceinline__ unsigned wave_min_u(unsigned v) {
    v = umin_(v, (unsigned)IDX_DPP((int)v, 0xB1)); v = umin_(v, (unsigned)IDX_DPP((int)v, 0x4E)); v = umin_(v, (unsigned)IDX_DPP((int)v, 0x141)); v = umin_(v, (unsigned)IDX_DPP((int)v, 0x140));
    return umin_(umin_((unsigned)__builtin_amdgcn_readlane((int)v, 0), (unsigned)__builtin_amdgcn_readlane((int)v, 16)), umin_((unsigned)__builtin_amdgcn_readlane((int)v, 32), (unsigned)__builtin_amdgcn_readlane((int)v, 48)));
}
__device__ __forceinline__ unsigned f2key(float v) { unsigned u = __float_as_uint(v); u = (u == 0x80000000u) ? 0u : u; return (u & 0x80000000u) ? ~u : (u | 0x80000000u); }
__device__ __forceinline__ float key2f(unsigned k) { return __uint_as_float((k & 0x80000000u) ? (k & 0x7fffffffu) : ~k); }

__device__ __forceinline__ void idx_unit(int b, int tb, const bf16* PROJ, unsigned* MASK, LAS unsigned char* shm, int tid) {
    const int lane = tid & 63, r32 = lane & 31, hi = lane >> 5; const int wid = __builtin_amdgcn_readfirstlane(tid >> 6);
    const long rowbase = (long)b * SEQ; const int t0 = tb * 16;
    LAS float* sc = (LAS float*)shm;
    if (t0 + 15 >= 256) {
        bf16x8 A[2][4]; float wv[2][4][4];
#pragma unroll
        for (int mb = 0; mb < 2; ++mb) {
            const bf16* qrow = PROJ + (rowbase + t0 + 8 * mb + (r32 >> 2)) * PITCH + C_IQ + (r32 & 3) * 64 + 8 * hi;
#pragma unroll
            for (int ks = 0; ks < 4; ++ks) A[mb][ks] = *reinterpret_cast<const bf16x8*>(qrow + 16 * ks);
#pragma unroll
            for (int g = 0; g < 4; ++g) { const bf16* wrow = PROJ + (rowbase + t0 + 8 * mb + 2 * g + hi) * PITCH + C_IW;
#pragma unroll
                for (int hh = 0; hh < 4; ++hh) wv[mb][g][hh] = bf2f(wrow[hh]) * 0.0625f; }
        }
        const int nkb = ((t0 + 15) >> 5) + 1;
        for (int kb = wid; kb < nkb; kb += 8) {
            const int s = 32 * kb + r32;
            const bf16* krow = PROJ + (rowbase + s) * PITCH + C_IK + 8 * hi;
            bf16x8 B[4];
#pragma unroll
            for (int ks = 0; ks < 4; ++ks) B[ks] = *reinterpret_cast<const bf16x8*>(krow + 16 * ks);
#pragma unroll
            for (int mb = 0; mb < 2; ++mb) {
                f32x16 acc = {};
#pragma unroll
                for (int ks = 0; ks < 4; ++ks) acc = __builtin_amdgcn_mfma_f32_32x32x16_bf16(A[mb][ks], B[ks], acc, 0, 0, 0);
#pragma unroll
                for (int g = 0; g < 4; ++g) {
                    float v = 0.f;
#pragma unroll
                    for (int hh = 0; hh < 4; ++hh) v += fmaxf(acc[4 * g + hh], 0.f) * wv[mb][g][hh];
                    sc[(8 * mb + 2 * g + hi) * 2048 + s] = v;
                }
            }
        }
    }
    __syncthreads();
#pragma unroll 1
    for (int rr = 0; rr < 2; ++rr) {
        const int q = 2 * wid + rr, t = t0 + q;
        unsigned long long mybits = 0ull;
        if (t < 256) {
            if (lane < 32) { const int lo = 64 * lane; mybits = (lo + 63 <= t) ? ~0ull : ((lo > t) ? 0ull : ((1ull << (t - lo + 1)) - 1ull)); }
        } else {
            unsigned k[32];
#pragma unroll
            for (int i = 0; i < 32; ++i) { const int s = 64 * i + lane; const unsigned kk = f2key(sc[q * 2048 + s]); k[i] = (s <= t) ? kk : 0u; }
            unsigned vmax = k[0], vmin = k[0] ? k[0] : 0xffffffffu;
#pragma unroll
            for (int i = 1; i < 32; ++i) { vmax = umax_(vmax, k[i]); vmin = umin_(vmin, k[i] ? k[i] : 0xffffffffu); }
            unsigned lo_k = wave_min_u(vmin), hi_k = wave_max_u(vmax) + 1u;
            int c_lo = t + 1, c_hi = 0;
            for (int it = 0; hi_k - lo_k > 1u; ++it) {
                unsigned m = lo_k + ((hi_k - lo_k) >> 1);
                if (it < 12) { const unsigned mv = f2key(0.5f * (key2f(lo_k) + key2f(hi_k))); if (mv > lo_k && mv < hi_k) m = mv; }
                int c = 0;
#pragma unroll
                for (int i = 0; i < 32; ++i) c += (k[i] >= m) ? 1 : 0;
                c = wave_sum_i(c);
                if (c >= 256) { lo_k = m; c_lo = c; if (c == 256) break; } else { hi_k = m; c_hi = c; }
            }
            if (c_lo == 256) {
#pragma unroll
                for (int i = 0; i < 32; ++i) { const unsigned long long bal = __ballot(k[i] >= lo_k); if (lane == i) mybits = bal; }
            } else {
                int remaining = 256 - c_hi;
#pragma unroll
                for (int i = 0; i < 32; ++i) {
                    const unsigned long long gt = __ballot(k[i] > lo_k), eq = __ballot(k[i] == lo_k);
                    const int rank = (int)__builtin_amdgcn_mbcnt_hi((unsigned)(eq >> 32), __builtin_amdgcn_mbcnt_lo((unsigned)eq, 0u));
                    const unsigned long long take = __ballot((k[i] == lo_k) && (rank < remaining));
                    const int ne = __builtin_popcountll(eq); remaining -= (ne < remaining) ? ne : remaining;
                    if (lane == i) mybits = gt | take;
                }
            }
        }
        if (lane < 32) *(unsigned long long*)(MASK + (rowbase + t) * 64 + 2 * lane) = mybits;
    }
    __syncthreads();
}
#undef IDX_DPP

__device__ __forceinline__ void kvdec_unit(int u, const bf16* PROJ, const bf16* WKVT, bf16* KD, bf16* VD, LAS unsigned char* shm, int tid) {
    const int lane = tid & 63, r32 = lane & 31, hi = lane >> 5; const int wid = __builtin_amdgcn_readfirstlane(tid >> 6);
    const int mr = wid >> 2, nc = wid & 3; const long m0 = (long)u * 64 + 32 * mr;
    const bf16* arow = PROJ + (m0 + r32) * PITCH + C_KVL + 8 * hi;
    const bf16* brow = WKVT + (32 * nc + r32) * 256 + 8 * hi;
    f32x16 acc = {}; float ss = 0.f;
#pragma unroll
    for (int kc = 0; kc < 4; ++kc) {
        bf16x8 a[4], bb[4];
#pragma unroll
        for (int j = 0; j < 4; ++j) { a[j] = *reinterpret_cast<const bf16x8*>(arow + 16 * (4 * kc + j)); bb[j] = *reinterpret_cast<const bf16x8*>(brow + 16 * (4 * kc + j)); }
#pragma unroll
        for (int j = 0; j < 4; ++j) {
#pragma unroll
            for (int e = 0; e < 8; ++e) { const float f = bf2f((unsigned short)a[j][e]); ss += f * f; }
            acc = __builtin_amdgcn_mfma_f32_32x32x16_bf16(a[j], bb[j], acc, 0, 0, 0);
        }
    }
    { const auto rr = __builtin_amdgcn_permlane32_swap(__float_as_uint(ss), __float_as_uint(ss), false, false); ss = __uint_as_float(rr[0]) + __uint_as_float(rr[1]); }
    LAS float* rs = (LAS float*)(shm + wid * 128);
    if (hi == 0) rs[r32] = rsqrtf(ss * (1.f / KV_LORA) + RMS_EPS);
    asm volatile("s_waitcnt lgkmcnt(0)" ::: "memory");
    bf16* dst = (nc < 2 ? KD : VD) + (nc & 1) * 32 + r32;
#pragma unroll
    for (int r = 0; r < 16; ++r) { const int row = att::crow(r, hi); dst[(m0 + row) * 64] = (bf16)f2bf(acc[r] * rs[row]); }
    asm volatile("s_waitcnt lgkmcnt(0)" ::: "memory");
}
}

namespace att {
constexpr int DSA_OST = NSLOT * SLOTB;
constexpr int DSA_WSF = DSA_OST + 32768;
constexpr int DSA_MSK = DSA_WSF + 1024;
constexpr int DSA_LDS_BYTES = DSA_MSK + 32 * 264;
constexpr float DSA_THR = 8.0f;
__device__ __forceinline__ void dsa_tile(lds_cptr kp, lds_cptr vp, const bf16x8 (&qr)[4], f32x16 (&o)[2], float& m_run, float& l, unsigned long long mbits, float slope2, float bl, int hi, int r32,
                                         LAS float* wsf) {
    f32x16 y[2];
#pragma unroll
    for (int p = 0; p < 2; ++p)
#pragma unroll
        for (int r = 0; r < 16; ++r) y[p][r] = __builtin_fmaf(slope2, (float)(32 * p + (r & 3) + 8 * (r >> 2)), bl);
#pragma unroll
    for (int d0 = 0; d0 < 4; ++d0) {
        const bf16x8 b0 = *(const __attribute__((address_space(3))) bf16x8*)(kp + d0 * 2048);
        const bf16x8 b1 = *(const __attribute__((address_space(3))) bf16x8*)(kp + d0 * 2048 + 512);
        y[0] = __builtin_amdgcn_mfma_f32_32x32x16_bf16(b0, qr[d0], y[0], 0, 0, 0); y[1] = __builtin_amdgcn_mfma_f32_32x32x16_bf16(b1, qr[d0], y[1], 0, 0, 0);
    }
    const unsigned ninf = 0xff800000u;
    const int w0 = (int)((unsigned)mbits >> (4 * hi)), w1 = (int)((unsigned)(mbits >> 32) >> (4 * hi));
    float cm = -INFINITY;
#pragma unroll
    for (int p = 0; p < 2; ++p)
#pragma unroll
        for (int r = 0; r < 16; ++r) {
            const unsigned mm = (unsigned)__builtin_amdgcn_sbfe(p ? w1 : w0, (r & 3) + 8 * (r >> 2), 1);
            const float v = __uint_as_float((__float_as_uint(y[p][r]) & mm) | (ninf & ~mm));
            y[p][r] = v; cm = fmaxf(cm, v);
        }
    { const auto rr = __builtin_amdgcn_permlane32_swap(__float_as_uint(cm), __float_as_uint(cm), false, false); cm = fmaxf(__uint_as_float(rr[0]), __uint_as_float(rr[1])); }
    const bool need = cm > m_run + DSA_THR;
    if (__any(need)) {
        const float alpha = need ? __builtin_amdgcn_exp2f(m_run - cm) : 1.0f;
        m_run = need ? cm : m_run; l *= alpha;
        if (hi == 0) wsf[r32] = alpha;
#pragma unroll
        for (int r = 0; r < 16; ++r) { const float a = wsf[crow(r, hi)]; o[0][r] *= a; o[1][r] *= a; }
    }
    const float m_safe = (m_run == -INFINITY) ? 0.f : m_run;
    u32x4 pw[4]; float ls = 0.f;
#pragma unroll
    for (int p = 0; p < 2; ++p)
#pragma unroll
        for (int g = 0; g < 4; ++g) {
            float a[4];
#pragma unroll
            for (int i = 0; i < 4; ++i) { a[i] = __builtin_amdgcn_exp2f(y[p][4 * g + i] - m_safe); ls += a[i]; }
            pw[2 * p + (g >> 1)][(g & 1) * 2 + 0] = cvtpk(a[0], a[1]);
            pw[2 * p + (g >> 1)][(g & 1) * 2 + 1] = cvtpk(a[2], a[3]);
        }
    l += ls;
#pragma unroll
    for (int d0 = 0; d0 < 2; ++d0)
#pragma unroll
        for (int ks = 0; ks < 4; ++ks) {
            const s16x4 lo = vtr(vp + d0 * 4096 + ks * 1024), hi4 = vtr(vp + d0 * 4096 + ks * 1024 + 512);
            const bf16x8 vf = {lo[0], lo[1], lo[2], lo[3], hi4[0], hi4[1], hi4[2], hi4[3]};
            o[d0] = __builtin_amdgcn_mfma_f32_32x32x16_bf16(__builtin_bit_cast(bf16x8, pw[ks]), vf, o[d0], 0, 0, 0);
        }
}
__device__ __forceinline__ void norm_row_512(const u32x4 v, const float* gain, bf16* dst, int lane) {
    float f[8];
#pragma unroll
    for (int e = 0; e < 4; ++e) { f[2 * e] = __uint_as_float(v[e] << 16); f[2 * e + 1] = __uint_as_float(v[e] & 0xffff0000u); }
    float ss = 0.f;
#pragma unroll
    for (int e = 0; e < 8; ++e) ss += f[e] * f[e];
    const float rstd = rsqrtf(wave_sum(ss) * (1.f / 512.f) + RMS_EPS);
    const f32x4 g0 = *(const f32x4*)(gain + lane * 8), g1 = *(const f32x4*)(gain + lane * 8 + 4);
    u32x4 w; w.x = cvtpk(f[0] * rstd * g0.x, f[1] * rstd * g0.y); w.y = cvtpk(f[2] * rstd * g0.z, f[3] * rstd * g0.w); w.z = cvtpk(f[4] * rstd * g1.x, f[5] * rstd * g1.y); w.w = cvtpk(f[6] * rstd * g1.z, f[7] * rstd * g1.w);
    *(u32x4*)(dst + lane * 8) = w;
}
__device__ __forceinline__ void dsa_unit(int b, int qb32, const bf16* PROJ, const bf16* KD, const bf16* VD, const unsigned* MASK, const bf16* OSB, const float* gsb, const float* gdsa, bf16* OCAT,
                                         LAS unsigned char* shm, int tid) {
    const int lane = tid & 63, r32 = lane & 31, hi = lane >> 5; const int wid = __builtin_amdgcn_readfirstlane(tid >> 6);
    const long rowbase = (long)b * SEQ; const int t0 = qb32 * 32;
    const bf16* Qw = PROJ + (rowbase + t0) * PITCH + C_DQ + wid * 64;
    const unsigned lds0 = (unsigned)(unsigned long)shm;
    const bf16* ksrc = KD + (rowbase + lane) * 64 + wid * 8;
    const bf16* vsrc = VD + (rowbase + 16 * (wid & 3) + (lane >> 2)) * 64 + (wid >> 2) * 32 + (lane & 3) * 8;
    const unsigned kdst = lds0 + wid * 1024, vdst = lds0 + VOFF + wid * 1024;
#define DSA_DMA(t, slot) do { glds16(ksrc + (long)(t) * 64 * 64, (unsigned)__builtin_amdgcn_readfirstlane(kdst + (slot) * SLOTB)); \
                              glds16(vsrc + (long)(t) * 64 * 64, (unsigned)__builtin_amdgcn_readfirstlane(vdst + (slot) * SLOTB)); } while (0)
    const lds_cptr shm3 = (lds_cptr)shm;
    const lds_cptr kp0 = shm3 + hi * 1024 + r32 * 16;
    const lds_cptr vp0 = shm3 + VOFF + ((lane >> 4) & 1) * 32 + (lane & 3) * 8 + (4 * hi + ((lane & 15) >> 2)) * 64;
    LAS float* wsf = (LAS float*)(shm + DSA_WSF) + wid * 32;
    const int NT = (t0 >> 6) + 1;
    DSA_DMA(0, 0);
    bf16x8 qr[4];
#pragma unroll
    for (int d0 = 0; d0 < 4; ++d0) qr[d0] = *reinterpret_cast<const bf16x8*>(&Qw[(long)r32 * PITCH + d0 * 16 + hi * 8]);
    {   const int row = tid >> 4, ch = tid & 15; const u32x4 v = *(const u32x4*)(MASK + (rowbase + t0 + row) * 64 + ch * 4);
        LAS unsigned long long* d = (LAS unsigned long long*)(shm + DSA_MSK + row * 264 + ch * 16);
        d[0] = (unsigned long long)v.x | ((unsigned long long)v.y << 32); d[1] = (unsigned long long)v.z | ((unsigned long long)v.w << 32); }
    const LAS unsigned long long* mrow = (const LAS unsigned long long*)(shm + DSA_MSK + r32 * 264);
    const float slope2 = __builtin_amdgcn_exp2f(-(float)(wid + 1)) * LOG2E;
    float bl = -slope2 * (float)(t0 + r32 - 4 * hi);
    f32x16 o[2]; o[0] = f32x16{}; o[1] = f32x16{};
    float m_run = -INFINITY, l = 0.f;
    int slot = 0;
    for (int jt = 0; jt < NT; ++jt) {
        const int nslot = (slot == NSLOT - 1) ? 0 : slot + 1;
        if (jt + 1 < NT) { DSA_DMA(jt + 1, nslot); ATT_WAIT_BAR(2); } else { ATT_WAIT_BAR(0); }
        const unsigned long long mcur = mrow[jt];
        dsa_tile(kp0 + slot * SLOTB, vp0 + slot * SLOTB, qr, o, m_run, l, mcur, slope2, bl, hi, r32, wsf);
        bl += 64.0f * slope2; slot = nslot;
    }
#undef DSA_DMA
    { const auto rr = __builtin_amdgcn_permlane32_swap(__float_as_uint(l), __float_as_uint(l), false, false); l = __uint_as_float(rr[0]) + __uint_as_float(rr[1]); }
    if (hi == 0) wsf[r32] = __builtin_amdgcn_rcpf(l);
    LAS unsigned short* ost = (LAS unsigned short*)(shm + DSA_OST);
#pragma unroll
    for (int r = 0; r < 16; ++r) { const int row = crow(r, hi); const float rl = wsf[row];
#pragma unroll
        for (int d0 = 0; d0 < 2; ++d0) ost[row * 512 + wid * 64 + d0 * 32 + r32] = (unsigned short)f2bf(o[d0][r] * rl); }
    asm volatile("s_waitcnt lgkmcnt(0)\n\ts_barrier" ::: "memory");
#pragma unroll
    for (int i = 0; i < 4; ++i) {
        const int row = 4 * wid + i; const long m = rowbase + t0 + row;
        const u32x4 vd = *(const LAS u32x4*)(ost + row * 512 + lane * 8);
        const u32x4 vs = *(const u32x4*)(OSB + m * 512 + lane * 8);
        norm_row_512(vs, gsb, OCAT + m * 1024, lane);
        norm_row_512(vd, gdsa, OCAT + m * 1024 + 512, lane);
    }
    asm volatile("s_waitcnt lgkmcnt(0)\n\ts_barrier" ::: "memory");
}
}

__global__ void __launch_bounds__(NWAVES * 64, 2) mega(Args args) {
    extern __shared__ __attribute__((aligned(16))) unsigned char lds[];
    LAS unsigned char* L = (LAS unsigned char*)lds;
    volatile LAS unsigned* MISC = (volatile LAS unsigned*)(L + MISC_OFF);
    const int G = gridDim.x, bx = blockIdx.x;
    const int vcu = (G % 8 == 0) ? (bx % 8) * (G / 8) + bx / 8 : bx;
    unsigned char* ws = args.ws;
    gu32* ctl = (gu32*)(ws + WS_CTL);
    for (int u = threadIdx.x; u < (LDS_BYTES - LDSCTL_OFF) / 4; u += NWAVES * 64) ((LAS unsigned*)(L + LDSCTL_OFF))[u] = 0u;
    __syncthreads();
    XcdBarrier bar; bar.bar = (unsigned*)(ctl + CW_BAR); bar.x = 0; bar.st = nullptr;
    const bool multi = (args.ph_hi - args.ph_lo) > 1;
    if (multi) bar = xcd_barrier_post((unsigned*)(ctl + CW_BAR), MISC + 8);

    float* mod0 = (float*)(ws + WS_MOD); float* modf = mod0 + 2 * 8 * 6144;
    bf16* XN = (bf16*)(ws + WS_XN); bf16* PROJ = (bf16*)(ws + WS_PROJ); bf16* OCAT = (bf16*)(ws + WS_OCAT);
    const int NGW = G * NWAVES;

    for (int ph = args.ph_lo; ph < args.ph_hi; ++ph) {
        if (ph > args.ph_lo) xcd_barrier(bar);
        int tid = threadIdx.x; asm volatile("" : "+v"(tid));
        const int lane = tid & 63, wave = __builtin_amdgcn_readfirstlane(tid >> 6), gw = vcu * NWAVES + wave;
        if (ph == PH_PRO) {
            LAS float* scr = (LAS float*)(L + RING_OFF + wave * 8448);
            constexpr int I_IN = 16 * 88, I_O = 16 * 32, I_G = 16 * 88, I_D = 44 * 32, I_LAYER = I_IN + I_O + 2 * I_G + I_D;
            for (int it = gw; it < DEPTH * I_LAYER; it += NGW) {
                const int l = it / I_LAYER; int r = it % I_LAYER;
                if (r < I_IN) { transpose_item(args.in[6] + (size_t)l * 1024 * IN_COLS, 1024, IN_COLS, (bf16*)(ws + WS_WIN + l * WIN_BYTES), scr, r / 88, r % 88, lane, RowId{}); continue; } r -= I_IN;
                if (r < I_O) { transpose_item(args.in[12] + (size_t)l * 1024 * 1024, 1024, 1024, (bf16*)(ws + WS_WO + l * WO_BYTES), scr, r / 32, r % 32, lane, RowId{}); continue; } r -= I_O;
                if (r < I_G) { transpose_item(args.in[13] + (size_t)l * 1024 * D_FF, 1024, D_FF, (bf16*)(ws + WS_WGU + l * WGU_BYTES), scr, r / 88, r % 88, lane, RowGU{0}); continue; } r -= I_G;
                if (r < I_G) { transpose_item(args.in[14] + (size_t)l * 1024 * D_FF, 1024, D_FF, (bf16*)(ws + WS_WGU + l * WGU_BYTES), scr, r / 88, r % 88, lane, RowGU{1}); continue; } r -= I_G;
                transpose_item(args.in[15] + (size_t)l * D_FF * 1024, D_FF, 1024, (bf16*)(ws + WS_WD + l * WD_BYTES), scr, r / 32, r % 32, lane, RowId{});
            }
            for (int i = gw * 64 + lane; i < DEPTH * 128 * 256; i += NGW * 64) { const int ll = i >> 15, n = (i >> 8) & 127, j = i & 255;
                const float w = (n < 64) ? args.in[8][(size_t)ll * 256 * 64 + j * 64 + n] : args.in[9][(size_t)ll * 256 * 64 + j * 64 + (n - 64)];
                ((bf16*)(ws + WS_WKV))[i] = (bf16)f2bf(w * args.in[7][ll * 256 + j]); }
            __syncthreads();
            LAS float* cact = (LAS float*)(L + 0);
            LAS float* red = (LAS float*)(L + 32768);
            for (int i = tid; i < 8192; i += NWAVES * 64) { const float v = args.in[1][i]; cact[i] = v / (1.f + __expf(-v)); }
            __syncthreads();
            constexpr int NIT = (2 * 6144 + 2048) / 64;
            for (int it = vcu; it < NIT; it += G) {
                const float* W; const float* bias; float* outp; int N, n0;
                if (it < 96) { W = args.in[2]; bias = args.in[3]; outp = mod0; N = 6144; n0 = it * 64; }
                else if (it < 192) { W = args.in[2] + (size_t)1024 * 6144; bias = args.in[3] + 6144; outp = mod0 + 8 * 6144; N = 6144; n0 = (it - 96) * 64; }
                else { W = args.in[16]; bias = args.in[17]; outp = modf; N = 2048; n0 = (it - 192) * 64; }
                float acc[8];
#pragma unroll
                for (int b = 0; b < 8; ++b) acc[b] = 0.f;
                const float* wp = W + (size_t)(wave * 128) * N + n0 + lane;
#pragma unroll 4
                for (int k = 0; k < 128; ++k) { const float w = wp[(size_t)k * N];
#pragma unroll
                    for (int b = 0; b < 8; ++b) acc[b] += cact[b * 1024 + wave * 128 + k] * w; }
#pragma unroll
                for (int b = 0; b < 8; ++b) red[(wave * 8 + b) * 64 + lane] = acc[b];
                __syncthreads();
                { const int b = wave; float s = 0.f;
#pragma unroll
                  for (int w = 0; w < 8; ++w) s += red[(w * 8 + b) * 64 + lane];
                  outp[(size_t)b * N + n0 + lane] = s + bias[n0 + lane]; }
                __syncthreads();
            }
        } else if (ph == PH_FINAL) {
            for (int m = gw; m < M; m += NGW) { const int b = m / SEQ; normmod_row_f32(args.out + (size_t)m * D_MODEL, args.in[18], modf + (size_t)b * 2048, modf + (size_t)b * 2048 + 1024, args.out + (size_t)m * D_MODEL, lane); }
        } else {
            const int l = (ph - PH_L0) / NSP, sp = (ph - PH_L0) % NSP;
            const float* mod = mod0 + (size_t)l * 8 * 6144;
            if (sp == SP_NORM1 || sp == SP_NORM2) {
                const float* xin = (sp == SP_NORM1 && l == 0) ? args.in[0] : args.out;
                const float* gain = (sp == SP_NORM1 ? args.in[4] : args.in[5]) + l * 1024;
                const int o = (sp == SP_NORM1) ? 0 : 3072;
                for (int m = gw; m < M; m += NGW) { const int b = m / SEQ; normmod_row_bf16(xin + (size_t)m * D_MODEL, gain, mod + (size_t)b * 6144 + o, mod + (size_t)b * 6144 + o + 1024, XN + (size_t)m * D_MODEL, lane); }
            } else if (sp == SP_INPROJ) {
                pg8::Gemm g{XN, (const bf16*)(ws + WS_WIN + l * WIN_BYTES), M, NPROJ, 1024}; pg8::StaticOrder S; S.init(M, NPROJ, G, bx);
                pg8::EpiProj E{PROJ, NPROJ, C2};
                pg8::gemm_phase<pg8::EpiProj, pg8::StaticOrder, true, true>(L + RING_OFF, g, S, E, tid);
            } else if (sp == SP_OUTPROJ) {
                pg8::Gemm g{OCAT, (const bf16*)(ws + WS_WO + l * WO_BYTES), M, 1024, 1024}; pg8::StaticOrder S; S.init(M, 1024, G, bx);
                pg8::EpiResid E{l == 0 ? args.in[0] : args.out, args.out, 1024, mod + 2048, 6144};
                pg8::gemm_phase<pg8::EpiResid, pg8::StaticOrder, true, true>(L + RING_OFF, g, S, E, tid);
            } else if (sp == SP_GATEUP) {
                pg8::Gemm g{XN, (const bf16*)(ws + WS_WGU + l * WGU_BYTES), M, NGU, 1024}; pg8::StaticOrder S; S.init(M, NGU, G, bx);
                pg8::EpiSwiGLU E{PROJ, D_FF};
                pg8::gemm_phase<pg8::EpiSwiGLU, pg8::StaticOrder, true, true>(L + RING_OFF, g, S, E, tid);
            } else if (sp == SP_DOWN) {
                pg8::Gemm g{PROJ, (const bf16*)(ws + WS_WD + l * WD_BYTES), M, 1024, D_FF}; pg8::StaticOrder S; S.init(M, 1024, G, bx);
                pg8::EpiResid E{args.out, args.out, 1024, mod + 5120, 6144};
                pg8::gemm_phase<pg8::EpiResid, pg8::StaticOrder, true, true>(L + RING_OFF, g, S, E, tid);
            }
            else if (sp == SP_MIX1) {
                for (int u = vcu; u < 512; u += G) { const int pi = u & 255, bh = pi >> 2, p = pi & 3, qb = (u >> 8) ? 7 - p : p;
                    att::sb_unit(bh >> 3, bh & 7, qb, PROJ, (bf16*)(ws + WS_OSB), L + RING_OFF, tid); }
            }
            if (sp == SP_MIX1) {
                for (int u = vcu; u < 1024; u += G) { const int k = u >> 8, v = u & 255, bb = v >> 5, j = v & 31; const int tb = (k == 0) ? j : (k == 1) ? 63 - j : (k == 2) ? 64 + j : 127 - j;
                    idx::idx_unit(bb, tb, PROJ, (unsigned*)(ws + WS_MASK), L + RING_OFF, tid); }
                for (int u = vcu; u < 256; u += G) idx::kvdec_unit(u, PROJ, (const bf16*)(ws + WS_WKV) + (size_t)l * 128 * 256, (bf16*)(ws + WS_KD), (bf16*)(ws + WS_VD), L + RING_OFF, tid);
            }
            if (sp == SP_MIX2) {
                for (int u = vcu; u < 512; u += G) { const int v = u & 255, bb = v >> 5, j = v & 31, qb32 = (u >> 8) ? 63 - j : j;
                    att::dsa_unit(bb, qb32, PROJ, (const bf16*)(ws + WS_KD), (const bf16*)(ws + WS_VD), (const unsigned*)(ws + WS_MASK), (const bf16*)(ws + WS_OSB),
                                  args.in[10] + l * 512, args.in[11] + l * 512, OCAT, L + RING_OFF, tid); }
            }
        }
    }
}

__global__ void __launch_bounds__(256) k_sb_attn_bf(const bf16* __restrict__ proj, bf16* __restrict__ osb) {
    __shared__ float qs[4][64];
    const int tid = threadIdx.x, lane = tid & 63, w = tid >> 6;
    const int wv = blockIdx.x * 4 + w;
    const int t = wv % SEQ, bh = wv / SEQ, h = bh % 8, b = bh / 8;
    const size_t mrow = (size_t)b * SEQ;
    qs[w][lane] = bf2f(proj[(mrow + t) * NPROJ + C_SBQ + h * 64 + lane]);
    __syncthreads();
    float carry = 0.f, o = 0.f;
    for (int s_hi = t - 1; s_hi >= 0; s_hi -= 64) {
        const int s = s_hi - lane; const bool valid = s >= 0;
        float y = 0.f;
        if (valid) { const bf16* kr = proj + (mrow + s) * NPROJ + C_SBK + h * 64; float d = 0.f;
#pragma unroll
            for (int i = 0; i < 64; ++i) d += qs[w][i] * bf2f(kr[i]);
            y = d; }
        const float lg = fmaxf(y, 0.f) + log2f(1.f + exp2f(-fabsf(y)));
        const float Lb = valid ? -lg : 0.f;
        float incl = Lb;
#pragma unroll
        for (int off = 1; off < 64; off <<= 1) { const float n = __shfl_up(incl, off); if (lane >= off) incl += n; }
        const float tail = carry + (incl - Lb);
        const float Aw = valid ? exp2f((y - lg) + tail) : 0.f;
        carry += __shfl(incl, 63);
        const int nvalid = (s_hi + 1 < 64) ? s_hi + 1 : 64;
        for (int j = 0; j < nvalid; ++j) { const float a = __shfl(Aw, j); o += a * bf2f(proj[(mrow + (s_hi - j)) * NPROJ + C_SBV + h * 64 + lane]); }
    }
    osb[(mrow + t) * 512 + h * 64 + lane] = (bf16)f2bf(o);
}
__global__ void __launch_bounds__(256) k_idx_bf(const bf16* __restrict__ proj, unsigned* __restrict__ mask) {
    __shared__ float qi[256];
    __shared__ float wi[4];
    __shared__ float score[SEQ];
    const int m = blockIdx.x, t = m % SEQ, b = m / SEQ, tid = threadIdx.x, lane = tid & 63;
    const size_t mrow = (size_t)b * SEQ;
    qi[tid] = bf2f(proj[(size_t)m * NPROJ + C_IQ + tid]);
    if (tid < 4) wi[tid] = bf2f(proj[(size_t)m * NPROJ + C_IW + tid]) * 0.5f;
    __syncthreads();
    const int n = t + 1;
    for (int s = tid; s < n; s += 256) {
        const bf16* kr = proj + (mrow + s) * NPROJ + C_IK;
        float d[4] = {0.f, 0.f, 0.f, 0.f};
#pragma unroll 8
        for (int i = 0; i < 64; ++i) { const float kv = bf2f(kr[i]);
#pragma unroll
            for (int hh = 0; hh < 4; ++hh) d[hh] += qi[hh * 64 + i] * kv; }
        float sc = 0.f;
#pragma unroll
        for (int hh = 0; hh < 4; ++hh) sc += fmaxf(d[hh] * 0.125f, 0.f) * wi[hh];
        score[s] = sc;
    }
    __syncthreads();
    for (int base = 0; base < SEQ; base += 256) {
        const int s = base + tid; bool sel = false;
        if (s < n) {
            if (n <= 256) sel = true;
            else { const float v = score[s]; int rank = 0;
                for (int j = 0; j < n; ++j) { const float u = score[j]; rank += (u > v || (u == v && j < s)) ? 1 : 0; }
                sel = rank < 256; }
        }
        const unsigned long long bal = __ballot(sel);
        if (lane == 0) { mask[(size_t)m * 64 + (s >> 5)] = (unsigned)bal; mask[(size_t)m * 64 + (s >> 5) + 1] = (unsigned)(bal >> 32); }
    }
}
__global__ void k_kvdec_bf(const bf16* __restrict__ proj, const float* __restrict__ kvg, const float* __restrict__ wuk, const float* __restrict__ wuv, bf16* __restrict__ kd, bf16* __restrict__ vd) {
    __shared__ float kvn[256];
    __shared__ float red[2];
    const int m = blockIdx.x, tid = threadIdx.x;
    const bf16* row = proj + (size_t)m * NPROJ + C_KVL;
    const float a = bf2f(row[tid]), b = bf2f(row[tid + 128]);
    float ss = a * a + b * b;
    for (int o = 32; o > 0; o >>= 1) ss += __shfl_xor(ss, o);
    if ((tid & 63) == 0) red[tid >> 6] = ss;
    __syncthreads();
    const float rstd = rsqrtf((red[0] + red[1]) * (1.f / KV_LORA) + RMS_EPS);
    kvn[tid] = a * rstd * kvg[tid]; kvn[tid + 128] = b * rstd * kvg[tid + 128];
    __syncthreads();
    const float* w = (tid < 64) ? wuk : wuv; const int n = tid & 63;
    float acc = 0.f;
    for (int j = 0; j < 256; ++j) acc += kvn[j] * w[j * 64 + n];
    if (tid < 64) kd[(size_t)m * 64 + n] = (bf16)f2bf(acc); else vd[(size_t)m * 64 + n] = (bf16)f2bf(acc);
}
__global__ void __launch_bounds__(256) k_dsa_bf(const bf16* __restrict__ proj, const bf16* __restrict__ kd, const bf16* __restrict__ vd, const unsigned* __restrict__ mask, bf16* __restrict__ odsa) {
    __shared__ float qs[4][64];
    const int tid = threadIdx.x, lane = tid & 63, w = tid >> 6;
    const int wv = blockIdx.x * 4 + w;
    const int h = wv % 8, m = wv / 8, t = m % SEQ, b = m / SEQ;
    const size_t mrow = (size_t)b * SEQ;
    qs[w][lane] = bf2f(proj[(size_t)m * NPROJ + C_DQ + h * 64 + lane]);
    __syncthreads();
    const float slope = exp2f(-(float)(h + 1)) * LOG2E;
    float mrun = -INFINITY, l = 0.f, o = 0.f;
    for (int s0 = 0; s0 <= t; s0 += 64) {
        const unsigned w0 = mask[(size_t)m * 64 + (s0 >> 5)], w1 = mask[(size_t)m * 64 + (s0 >> 5) + 1];
        const unsigned long long bits = ((unsigned long long)w1 << 32) | w0;
        if (bits == 0ull) continue;
        const int s = s0 + lane; const bool sel = (bits >> lane) & 1ull;
        float logit = -INFINITY;
        if (sel) { const bf16* kr = kd + (mrow + s) * 64; float d = 0.f;
#pragma unroll
            for (int i = 0; i < 64; ++i) d += qs[w][i] * bf2f(kr[i]);
            logit = d - slope * (float)(t - s); }
        float cmax = logit;
        for (int off = 32; off > 0; off >>= 1) cmax = fmaxf(cmax, __shfl_xor(cmax, off));
        const float nm = fmaxf(mrun, cmax);
        const float alpha = exp2f(mrun - nm);
        const float p = sel ? exp2f(logit - nm) : 0.f;
        float ps = p;
        for (int off = 32; off > 0; off >>= 1) ps += __shfl_xor(ps, off);
        l = l * alpha + ps; o *= alpha; mrun = nm;
        for (int j = 0; j < 64; ++j) if ((bits >> j) & 1ull) { const float pj = __shfl(p, j); o += pj * bf2f(vd[(mrow + s0 + j) * 64 + lane]); }
    }
    odsa[(size_t)m * 512 + h * 64 + lane] = (bf16)f2bf(o / l);
}
__global__ void k_outnorm_bf(const bf16* __restrict__ osb, const bf16* __restrict__ odsa, const float* __restrict__ gsb, const float* __restrict__ gdsa, bf16* __restrict__ ocat) {
    __shared__ float red[4];
    const int m = blockIdx.x, tid = threadIdx.x;
    const bf16* src = (tid < 128) ? osb + (size_t)m * 512 + tid * 4 : odsa + (size_t)m * 512 + (tid - 128) * 4;
    float v[4]; float ss = 0.f;
#pragma unroll
    for (int j = 0; j < 4; ++j) { v[j] = bf2f(src[j]); ss += v[j] * v[j]; }
    for (int o = 32; o > 0; o >>= 1) ss += __shfl_xor(ss, o);
    if ((tid & 63) == 0) red[tid >> 6] = ss;
    __syncthreads();
    const float tot = (tid < 128) ? (red[0] + red[1]) : (red[2] + red[3]);
    const float rstd = rsqrtf(tot * (1.f / 512.f) + RMS_EPS);
    const float* g = (tid < 128) ? gsb + tid * 4 : gdsa + (tid - 128) * 4;
#pragma unroll
    for (int j = 0; j < 4; ++j) ocat[(size_t)m * 1024 + tid * 4 + j] = (bf16)f2bf(v[j] * rstd * g[j]);
}

extern "C" void kernel_launch(void* const* d_in, const int* in_sizes, int n_in, void* d_out, int out_size, void* d_ws, size_t ws_size, hipStream_t stream) {
    static int grid = 0;
    if (grid == 0) {
        if (n_in != 19 || out_size != M * D_MODEL || ws_size < WS_END) { fprintf(stderr, "kernel_launch: unexpected problem shape (n_in %d out %d ws %zu)\n", n_in, out_size, ws_size); grid = -1; return; }
        int dev = 0, cus = 0;
        if (hipGetDevice(&dev) != hipSuccess || hipDeviceGetAttribute(&cus, hipDeviceAttributeMultiprocessorCount, dev) != hipSuccess) { grid = -1; return; }
        if (hipFuncSetAttribute((const void*)mega, hipFuncAttributeMaxDynamicSharedMemorySize, LDS_BYTES) != hipSuccess) { fprintf(stderr, "kernel_launch: hipFuncSetAttribute failed\n"); grid = -1; return; }
        (void)hipGetLastError();
        grid = cus;
    }
    if (grid < 0) return;
    (void)hipMemsetAsync((char*)d_ws + WS_CTL, 0, CTL_ZERO_BYTES, stream);
    Args a{};
    for (int i = 0; i < 19; ++i) a.in[i] = (const float*)d_in[i];
    a.out = (float*)d_out; a.ws = (unsigned char*)d_ws;
    char* ws = (char*)d_ws;
    const bf16* PROJ = (const bf16*)(ws + WS_PROJ);
    auto run = [&](int lo, int hi) { a.ph_lo = lo; a.ph_hi = hi; hipLaunchKernelGGL(mega, dim3(grid), dim3(NWAVES * 64), LDS_BYTES, stream, a); };
    (void)PROJ; run(PH_PRO, NPHASE);
}
```

```cpp
#include <hip/hip_runtime.h>
#include <cstdio>
#include <cstdint>
#include <cmath>
namespace pg8 {
#define PG8_LAS __attribute__((address_space(3)))
typedef unsigned short bf16_t;
typedef short bf16x8 __attribute__((ext_vector_type(8)));
typedef float f32x4 __attribute__((ext_vector_type(4)));
typedef unsigned u32x4 __attribute__((ext_vector_type(4)));
constexpr int BM = 256, BK = 64, HALF = 128, HTB = HALF * BK * 2  , STAGE_BYTES = 8 * HTB, NXCD = 8, WGM = 8;

__host__ __device__ __forceinline__ int lds_byte(int r, int c) { const int st = (r >> 4) * 2 + (c >> 5), rr = r & 15, cc = c & 31, ob = rr * 64 + cc * 2; return st * 1024 + (ob ^ (((ob >> 9) & 1) << 5)); }
__host__ __device__ __forceinline__ void stage_rc(int b, int& R, int& C) { const int st = b / 1024, sb = b % 1024, swz = sb ^ (((sb >> 9) & 1) << 5); R = (st >> 1) * 16 + swz / 64; C = (st & 1) * 32 + (swz % 64) / 2; }
__host__ __device__ __forceinline__ int perm32(int rho) { const int n = rho >> 4, i = rho & 15; return 8 * (i >> 2) + 4 * n + (i & 3); }

struct Unit { int pm, pn; };
struct Gemm { const bf16_t* A; const bf16_t* Bt; int M, N, K; };

struct StaticOrder {
    int nM, nN, nwg, G, c;
    __host__ __device__ void init(int M, int N, int G_, int c_) { nM = M / BM; nN = N / BM; nwg = nM * nN; G = G_; c = c_; }
    __host__ __device__ bool next(int i, Unit& u) const {
        const long L = (long)i * G + c; if (L >= nwg) return false;
        int wgid = (int)L; { const int q = nwg / NXCD, r = nwg % NXCD, xcd = wgid % NXCD, off = wgid / NXCD; wgid = (xcd < r ? xcd * (q + 1) : r * (q + 1) + (xcd - r) * q) + off; }
        const int nig = WGM * nN, gid = wgid / nig, fm = gid * WGM, gsz = (nM - fm) < WGM ? (nM - fm) : WGM;
        u.pm = fm + ((wgid % nig) % gsz); u.pn = (wgid % nig) / gsz; return true;
    }
    __device__ __forceinline__ void a_ready(const Unit&) const {}
    __device__ __forceinline__ void done(const Unit&) const {}
};

__device__ __forceinline__ unsigned cvt_pk_bf16(float lo, float hi) { unsigned r; asm volatile("v_cvt_pk_bf16_f32 %0, %1, %2" : "=v"(r) : "v"(lo), "v"(hi)); return r; }
typedef float f32x2 __attribute__((ext_vector_type(2)));
__device__ __forceinline__ float silu_f(float g) { return g * __builtin_amdgcn_rcpf(1.0f + __builtin_amdgcn_exp2f(-1.4426950408889634f * g)); }
struct EpiProj {
    static constexpr bool PERM = true, AFTER_DRAIN = false;
    bf16_t* O; int ldc; float qscale;
    __device__ __forceinline__ void operator()(const f32x4 (&acc)[2][2][4][2], const Unit& u, int wr, int wc, int fr, int fq) const {
        const int row0 = u.pm * BM + wr * 64 + fr, col0 = u.pn * BM + wc * 32 + 8 * fq;
        const float sc = (u.pn < 2 || u.pn == 6 || u.pn == 7) ? qscale : 1.0f;
#pragma unroll
        for (int ai = 0; ai < 2; ++ai)
#pragma unroll
            for (int m = 0; m < 4; ++m) { bf16_t* rowp = O + (size_t)(row0 + ai * HALF + m * 16) * ldc + col0;
#pragma unroll
                for (int bj = 0; bj < 2; ++bj) { const f32x4 v0 = acc[ai][bj][m][0] * sc, v1 = acc[ai][bj][m][1] * sc;
                    u32x4 w; w.x = cvt_pk_bf16(v0[0], v0[1]); w.y = cvt_pk_bf16(v0[2], v0[3]); w.z = cvt_pk_bf16(v1[0], v1[1]); w.w = cvt_pk_bf16(v1[2], v1[3]);
                    *(u32x4*)(rowp + bj * HALF) = w; } }
    }
};
struct EpiSwiGLU {
    static constexpr bool PERM = true, AFTER_DRAIN = false;
    bf16_t* Hb; int ldh;
    __device__ __forceinline__ void operator()(const f32x4 (&acc)[2][2][4][2], const Unit& u, int wr, int wc, int fr, int fq) const {
        const int row0 = u.pm * BM + wr * 64 + fr, col0 = u.pn * HALF + wc * 32 + 8 * fq;
#pragma unroll
        for (int ai = 0; ai < 2; ++ai)
#pragma unroll
            for (int m = 0; m < 4; ++m) { bf16_t* rowp = Hb + (size_t)(row0 + ai * HALF + m * 16) * ldh + col0;
                const f32x4 g0 = acc[ai][0][m][0], g1 = acc[ai][0][m][1], u0 = acc[ai][1][m][0], u1 = acc[ai][1][m][1];
                u32x4 w;
                w.x = cvt_pk_bf16(silu_f(g0[0]) * u0[0], silu_f(g0[1]) * u0[1]); w.y = cvt_pk_bf16(silu_f(g0[2]) * u0[2], silu_f(g0[3]) * u0[3]);
                w.z = cvt_pk_bf16(silu_f(g1[0]) * u1[0], silu_f(g1[1]) * u1[1]); w.w = cvt_pk_bf16(silu_f(g1[2]) * u1[2], silu_f(g1[3]) * u1[3]);
                *(u32x4*)rowp = w; }
    }
};
struct EpiResid {
    static constexpr bool PERM = false, AFTER_DRAIN = false;
    const float* R; float* out; int ldc; const float* gate; int gstride;
    __device__ __forceinline__ void operator()(const f32x4 (&acc)[2][2][4][2], const Unit& u, int wr, int wc, int fr, int fq) const {
        const int col0 = u.pn * BM + wc * 32 + 4 * fq; const float* gb = gate + (size_t)(u.pm >> 3) * gstride;
        f32x4 gv[2][2];
#pragma unroll
        for (int bj = 0; bj < 2; ++bj)
#pragma unroll
            for (int n = 0; n < 2; ++n) gv[bj][n] = *(const f32x4*)(gb + col0 + bj * HALF + n * 16);
#pragma unroll
        for (int ai = 0; ai < 2; ++ai)
#pragma unroll
            for (int m = 0; m < 4; ++m) { const size_t off = (size_t)(u.pm * BM + ai * HALF + wr * 64 + m * 16 + fr) * ldc + col0;
#pragma unroll
                for (int bj = 0; bj < 2; ++bj)
#pragma unroll
                    for (int n = 0; n < 2; ++n) { const f32x4 r = *(const f32x4*)(R + off + bj * HALF + n * 16); *(f32x4*)(out + off + bj * HALF + n * 16) = r + gv[bj][n] * acc[ai][bj][m][n]; } }
    }
};
template <class Epi, class Sched, bool ALIGN_EPI = false, bool SP2 = false>
__device__ __forceinline__ void gemm_phase(PG8_LAS unsigned char* lds, const Gemm g, const Sched& S, const Epi& E, const int tid) {
    const int wid = __builtin_amdgcn_readfirstlane(tid >> 6), lane = tid & 63, wr = wid >> 2, wc = wid & 3, fr = lane & 15, fq = lane >> 4;
    const int K = g.K, nt = K / BK;
    unsigned voffA[2], voffB[2];
#pragma unroll
    for (int i = 0; i < 2; ++i) { int R, C; stage_rc(tid * 16 + i * 8192, R, C); const int Rb = Epi::PERM ? ((R & ~31) + perm32(R & 31)) : R;
        voffA[i] = (unsigned)(R * K + C) * 2u; voffB[i] = (unsigned)(Rb * K + C) * 2u; }
    const size_t kstep = (size_t)(BK * 2);
    const size_t hstep = (size_t)HALF * K * 2;
    const size_t tstep = 2 * hstep;
    const unsigned ldsw = (unsigned)wid * 1024u;
    const int aoff = lds_byte(wr * 64 + fr, fq * 8), boff = lds_byte(wc * 32 + fr, fq * 8);
#define PG8_SA(b, h) (((b) * 2 + (h)) * HTB)
#define PG8_SB(b, h) ((4 + (b) * 2 + (h)) * HTB)
#define PG8_STAGE(bufoff, gbase, voff) do { _Pragma("unroll") for (int _i = 0; _i < 2; ++_i) \
        __builtin_amdgcn_global_load_lds((const unsigned*)((const char*)(gbase) + (voff)[_i]), (PG8_LAS unsigned*)(lds + (bufoff) + ldsw + _i * 8192), 16, 0, 0); } while (0)
#define PG8_LDA(dst, b, h) do { _Pragma("unroll") for (int m = 0; m < 4; ++m) _Pragma("unroll") for (int k = 0; k < 2; ++k) dst[m][k] = *(const PG8_LAS bf16x8*)(lds + PG8_SA(b, h) + aoff + m * 2048 + k * 1024); } while (0)
#define PG8_LDB(dst, b, h) do { _Pragma("unroll") for (int n = 0; n < 2; ++n) _Pragma("unroll") for (int k = 0; k < 2; ++k) dst[n][k] = *(const PG8_LAS bf16x8*)(lds + PG8_SB(b, h) + boff + n * 2048 + k * 1024); } while (0)
#define PG8_MMA(ai, bj, At, Bt) do { __builtin_amdgcn_s_setprio(1); _Pragma("unroll") for (int m = 0; m < 4; ++m) _Pragma("unroll") for (int n = 0; n < 2; ++n) _Pragma("unroll") for (int k = 0; k < 2; ++k) \
        acc[ai][bj][m][n] = __builtin_amdgcn_mfma_f32_16x16x32_bf16(Bt[n][k], At[m][k], acc[ai][bj][m][n], 0, 0, 0); __builtin_amdgcn_s_setprio(0); } while (0)
#define PG8_WAIT_V(n) asm volatile("s_waitcnt vmcnt(" #n ")" ::: "memory")
#define PG8_WAIT_L(n) asm volatile("s_waitcnt lgkmcnt(" #n ")" ::: "memory")
#define PG8_BAR __builtin_amdgcn_s_barrier()
#define PG8_SCHED __builtin_amdgcn_sched_barrier(0)
    Unit cur, nxt; int ui = 0;
    if (!S.next(0, cur)) return;
    f32x4 acc[2][2][4][2];
#pragma unroll
    for (int a = 0; a < 2; ++a)
#pragma unroll
        for (int b = 0; b < 2; ++b)
#pragma unroll
            for (int m = 0; m < 4; ++m)
#pragma unroll
                for (int n = 0; n < 2; ++n) acc[a][b][m][n] = (f32x4){0.f, 0.f, 0.f, 0.f};
    bf16x8 At[4][2], B0[2][2], B1[2][2];
    const char* cA = (const char*)g.A + (size_t)cur.pm * tstep; const char* cB = (const char*)g.Bt + (size_t)cur.pn * tstep;
    S.a_ready(cur);
    if constexpr (SP2) {
        PG8_STAGE(PG8_SB(0, 0), cB, voffB); PG8_STAGE(PG8_SB(0, 1), cB + hstep, voffB); PG8_STAGE(PG8_SA(0, 0), cA, voffA); PG8_STAGE(PG8_SA(0, 1), cA + hstep, voffA);
        if (wr == 1) PG8_BAR;
        PG8_WAIT_V(2); PG8_BAR;
        PG8_STAGE(PG8_SB(1, 0), cB + kstep, voffB); PG8_STAGE(PG8_SA(1, 0), cA + kstep, voffA); PG8_STAGE(PG8_SB(1, 1), cB + hstep + kstep, voffB);
        PG8_WAIT_V(6); PG8_BAR;
    } else {
        PG8_STAGE(PG8_SB(0, 0), cB, voffB); PG8_STAGE(PG8_SA(0, 0), cA, voffA); PG8_STAGE(PG8_SB(0, 1), cB + hstep, voffB); PG8_STAGE(PG8_SA(0, 1), cA + hstep, voffA);
        if (wr == 1) PG8_BAR;
        PG8_WAIT_V(4); PG8_BAR;
        PG8_STAGE(PG8_SB(1, 0), cB + kstep, voffB); PG8_STAGE(PG8_SA(1, 0), cA + kstep, voffA); PG8_STAGE(PG8_SB(1, 1), cB + hstep + kstep, voffB);
        PG8_WAIT_V(6); PG8_BAR;
    }
    for (;;) {
        const bool has_next = S.next(ui + 1, nxt);
        const char* nA = has_next ? (const char*)g.A + (size_t)nxt.pm * tstep : cA; const char* nB = has_next ? (const char*)g.Bt + (size_t)nxt.pn * tstep : cB;
        for (int t = 0; t < nt; t += 2) {
            const bool last = (t == nt - 2);
            const char* a1 = cA + (size_t)(t + 1) * kstep;
            const char* a2 = last ? nA : cA + (size_t)(t + 2) * kstep; const char* b2 = last ? nB : cB + (size_t)(t + 2) * kstep;
            const char* a3 = a2 + kstep; const char* b3 = b2 + kstep;
            if (last && has_next) S.a_ready(nxt);
            if constexpr (SP2) {
            PG8_LDB(B0, 0, 0); PG8_LDB(B1, 0, 1); PG8_SCHED; PG8_LDA(At, 0, 0); PG8_STAGE(PG8_SA(1, 1), a1 + hstep, voffA);
            PG8_WAIT_V(8); PG8_WAIT_L(0); PG8_BAR; PG8_MMA(0, 0, At, B0); PG8_MMA(0, 1, At, B1); PG8_BAR; PG8_SCHED;
            PG8_LDA(At, 0, 1); PG8_STAGE(PG8_SB(0, 0), b2, voffB); PG8_STAGE(PG8_SB(0, 1), b2 + hstep, voffB); PG8_STAGE(PG8_SA(0, 0), a2, voffA);
            PG8_WAIT_V(8); PG8_WAIT_L(0); PG8_BAR; PG8_MMA(1, 0, At, B0); PG8_MMA(1, 1, At, B1); PG8_BAR; PG8_SCHED;
            PG8_LDB(B0, 1, 0); PG8_LDB(B1, 1, 1); PG8_SCHED; PG8_LDA(At, 1, 0); PG8_STAGE(PG8_SA(0, 1), a2 + hstep, voffA);
            PG8_WAIT_V(8); PG8_WAIT_L(0); PG8_BAR; PG8_MMA(0, 0, At, B0); PG8_MMA(0, 1, At, B1); PG8_BAR; PG8_SCHED;
            PG8_LDA(At, 1, 1); PG8_STAGE(PG8_SB(1, 0), b3, voffB); PG8_STAGE(PG8_SB(1, 1), b3 + hstep, voffB); PG8_STAGE(PG8_SA(1, 0), a3, voffA);
            PG8_WAIT_V(8); PG8_WAIT_L(0); PG8_BAR; PG8_MMA(1, 0, At, B0); PG8_MMA(1, 1, At, B1); PG8_BAR; PG8_SCHED;
            } else {
            PG8_LDB(B0, 0, 0); PG8_SCHED; PG8_LDA(At, 0, 0); PG8_STAGE(PG8_SA(1, 1), a1 + hstep, voffA);
            PG8_WAIT_L(8); PG8_BAR; PG8_WAIT_L(0); PG8_MMA(0, 0, At, B0); PG8_BAR; PG8_SCHED;
            PG8_LDB(B1, 0, 1); PG8_STAGE(PG8_SB(0, 0), b2, voffB);
            PG8_BAR; PG8_WAIT_L(0); PG8_MMA(0, 1, At, B1); PG8_BAR;
            PG8_LDA(At, 0, 1); PG8_STAGE(PG8_SA(0, 0), a2, voffA);
            PG8_BAR; PG8_WAIT_L(0); PG8_MMA(1, 0, At, B0); PG8_BAR; PG8_SCHED;
            PG8_STAGE(PG8_SB(0, 1), b2 + hstep, voffB);
            PG8_WAIT_V(6); PG8_BAR; PG8_MMA(1, 1, At, B1); PG8_BAR;
            PG8_LDB(B0, 1, 0); PG8_SCHED; PG8_LDA(At, 1, 0); PG8_STAGE(PG8_SA(0, 1), a2 + hstep, voffA);
            PG8_WAIT_L(8); PG8_BAR; PG8_WAIT_L(0); PG8_MMA(0, 0, At, B0); PG8_BAR; PG8_SCHED;
            PG8_LDB(B1, 1, 1); PG8_STAGE(PG8_SB(1, 0), b3, voffB);
            PG8_BAR; PG8_WAIT_L(0); PG8_MMA(0, 1, At, B1); PG8_BAR;
            PG8_LDA(At, 1, 1); PG8_STAGE(PG8_SA(1, 0), a3, voffA);
            PG8_BAR; PG8_WAIT_L(0); PG8_MMA(1, 0, At, B0); PG8_BAR; PG8_SCHED;
            PG8_STAGE(PG8_SB(1, 1), b3 + hstep, voffB);
            PG8_WAIT_V(6); PG8_BAR; PG8_MMA(1, 1, At, B1); PG8_BAR;
            }
        }
        if constexpr (ALIGN_EPI) { if (wr == 0) PG8_BAR; }
        if constexpr (!Epi::AFTER_DRAIN) { E(acc, cur, wr, wc, fr, fq); S.done(cur); }
        if (!has_next) break;
#pragma unroll
        for (int a = 0; a < 2; ++a)
#pragma unroll
            for (int b = 0; b < 2; ++b)
#pragma unroll
                for (int m = 0; m < 4; ++m)
#pragma unroll
                    for (int n = 0; n < 2; ++n) acc[a][b][m][n] = (f32x4){0.f, 0.f, 0.f, 0.f};
        cur = nxt; cA = nA; cB = nB; ++ui;
        if constexpr (ALIGN_EPI) { if (wr == 1) PG8_BAR; }
    }
    PG8_WAIT_V(0);
    if constexpr (!ALIGN_EPI) { if (wr == 0) PG8_BAR; }
    PG8_BAR;
    if constexpr (Epi::AFTER_DRAIN) { E.fused(acc, cur, wr, wc, fr, fq, lds, wid, lane); S.done(cur); }
#undef PG8_SA
#undef PG8_SB
#undef PG8_STAGE
#undef PG8_LDA
#undef PG8_LDB
#undef PG8_MMA
#undef PG8_WAIT_V
#undef PG8_WAIT_L
#undef PG8_BAR
#undef PG8_SCHED
}
}

#define GAS __attribute__((address_space(1)))
#define LAS __attribute__((address_space(3)))
typedef unsigned short bf16;
typedef unsigned v4u __attribute__((ext_vector_type(4)));
typedef float f32x4 __attribute__((ext_vector_type(4)));
typedef short bf16x8 __attribute__((ext_vector_type(8)));
typedef GAS unsigned gu32;
typedef GAS unsigned long long gu64;
#define RLX_AGENT __ATOMIC_RELAXED, __HIP_MEMORY_SCOPE_AGENT
#define LDS_WAIT() asm volatile("s_waitcnt lgkmcnt(0)" ::: "memory")
#define VM_WAIT() asm volatile("s_waitcnt vmcnt(0)" ::: "memory")
__device__ __forceinline__ unsigned long long rt() { return __builtin_amdgcn_s_memrealtime(); }
__device__ __forceinline__ unsigned f2bf(float f) { unsigned u = __builtin_bit_cast(unsigned, f); return (u + 0x7fffu + ((u >> 16) & 1u)) >> 16; }
__device__ __forceinline__ unsigned pk2(float lo, float hi) { return f2bf(lo) | (f2bf(hi) << 16); }

#define XB_TMO      128
#define XB_XCNT(j)  (256  + 64 * (j))
#define XB_XSUB(j)  (1280 + 64 * (j))
#define XB_XGEN(j)  (2304 + 64 * (j))
#define XB_TOP      3328
#define XB_TOPGEN   3392
#define XCD_BAR_WORDS 3456
#define XB_SPIN_CAP (1u << 18)

__device__ __forceinline__ unsigned xb_ld(unsigned* p)              { return __hip_atomic_load(p, __ATOMIC_RELAXED, __HIP_MEMORY_SCOPE_AGENT); }
__device__ __forceinline__ unsigned xb_add(unsigned* p, unsigned v) { return __hip_atomic_fetch_add(p, v, __ATOMIC_RELAXED, __HIP_MEMORY_SCOPE_AGENT); }
__device__ __forceinline__ unsigned xb_xcc_id() { return (unsigned)__builtin_amdgcn_s_getreg((3 << 11) | 20) & 0xFu; }
#define XB_SPIN(cond, bar) do { unsigned _sp = 0; while (cond) { __builtin_amdgcn_s_sleep(1); \
    if ((++_sp & 255u) == 0u) { if (xb_ld(&(bar)[XB_TMO])) break; if (_sp > XB_SPIN_CAP) { atomicAdd(&(bar)[XB_TMO], 1u); break; } } } } while (0)

struct XcdBarrier {
    unsigned* bar; unsigned x;
    volatile LAS unsigned* st;
};

__device__ __forceinline__ XcdBarrier xcd_barrier_post(unsigned* bar, volatile LAS unsigned* st) {
    XcdBarrier b; b.bar = bar; b.x = xb_xcc_id(); b.st = st;
    if (threadIdx.x == 0) (void)xb_add(&bar[XB_XCNT(b.x)], 1u);
    return b;
}
__device__ __forceinline__ void xcd_barrier_complete(unsigned* bar, unsigned x, unsigned& nloc, unsigned& nx) {
    const unsigned G = gridDim.x * gridDim.y * gridDim.z;
    unsigned sum, cnt, mine, sp = 0u;
    for (;;) {
        sum = 0u; cnt = 0u; mine = 0u;
#pragma unroll
        for (unsigned j = 0; j < 16; ++j) { const unsigned c = xb_ld(&bar[XB_XCNT(j)]); sum += c; cnt += (c > 0u) ? 1u : 0u; mine = (j == x) ? c : mine; }
        if (sum == G) break;
        __builtin_amdgcn_s_sleep(1);
        if ((++sp & 255u) == 0u) { if (xb_ld(&bar[XB_TMO])) break; if (sp > XB_SPIN_CAP) { atomicAdd(&bar[XB_TMO], 1u); break; } }
    }
    nloc = mine > 0u ? mine : 1u; nx = cnt > 0u ? cnt : 1u;
}

__device__ __forceinline__ void xcd_barrier(const XcdBarrier& b) {
    asm volatile("s_waitcnt vmcnt(0)" ::: "memory");
    __syncthreads();
    if (threadIdx.x == 0) {
        unsigned* bar = b.bar;
        __builtin_amdgcn_s_waitcnt(0);
        unsigned nloc = b.st[0], nx = b.st[1];
        if (nloc == 0u) { xcd_barrier_complete(bar, b.x, nloc, nx); b.st[0] = nloc; b.st[1] = nx; }
        const unsigned old = xb_add(&bar[XB_XSUB(b.x)], 1u);
        const unsigned gen = old / nloc;
        if (old + 1u == (gen + 1u) * nloc) {
            __builtin_amdgcn_fence(__ATOMIC_RELEASE, "agent");
            asm volatile("s_waitcnt vmcnt(0)" ::: "memory");
            const unsigned og = xb_add(&bar[XB_TOP], 1u);
            const unsigned tg = og / nx;
            if (og + 1u == (tg + 1u) * nx) xb_add(&bar[XB_TOPGEN], 1u);
            else XB_SPIN(xb_ld(&bar[XB_TOPGEN]) == tg, bar);
            __builtin_amdgcn_fence(__ATOMIC_ACQUIRE, "agent");
            xb_add(&bar[XB_XGEN(b.x)], 1u);
            asm volatile("s_waitcnt vmcnt(0)" ::: "memory");
        } else {
            XB_SPIN(xb_ld(&bar[XB_XGEN(b.x)]) == gen, bar);
            __builtin_amdgcn_fence(__ATOMIC_ACQUIRE, "agent");
            asm volatile("s_waitcnt vmcnt(0)" ::: "memory");
        }
    }
    __syncthreads();
}

constexpr int NWAVES = 8;
constexpr int D_MODEL = 1024, BATCH = 8, SEQ = 2048, DEPTH = 2, M = BATCH * SEQ;
constexpr int IN_COLS = 2628, NPROJ = 2816, D_FF = 2816, NGU = 2 * D_FF, KV_LORA = 256;
constexpr int C_SBQ = 0, C_SBK = 512, C_SBV = 1024, C_DQ = 1536, C_KVL = 2048, C_IQ = 2304, C_IK = 2560, C_IW = 2624;
constexpr float RMS_EPS = 1e-6f;
constexpr float LOG2E = 1.4426950408889634f;
constexpr float C2 = 0.125f * LOG2E;
constexpr size_t MiB = 1u << 20;
constexpr size_t WS_CTL = 0, CTL_ZERO_BYTES = 1 * MiB;
constexpr size_t WS_MOD = 1 * MiB;
constexpr size_t WS_WKV = 1 * MiB + 512 * 1024;
constexpr size_t WS_WIN = 2 * MiB, WIN_BYTES = (size_t)NPROJ * 1024 * 2;
constexpr size_t WS_WO = 13 * MiB, WO_BYTES = (size_t)1024 * 1024 * 2;
constexpr size_t WS_WGU = 17 * MiB, WGU_BYTES = (size_t)NGU * 1024 * 2;
constexpr size_t WS_WD = 39 * MiB, WD_BYTES = (size_t)1024 * D_FF * 2;
constexpr size_t WS_XN = 50 * MiB;
constexpr size_t WS_PROJ = 82 * MiB;
constexpr size_t WS_OSB = 170 * MiB;
constexpr size_t WS_OCAT = 186 * MiB;
constexpr size_t WS_KD = 218 * MiB, WS_VD = 220 * MiB;
constexpr size_t WS_MASK = 222 * MiB;
constexpr size_t WS_ODSA = 226 * MiB;
constexpr size_t WS_END = 242 * MiB;
constexpr int CW_BAR = 4096;
constexpr int RING_OFF = 0, RING_BYTES = 131072;
constexpr int LDSCTL_OFF = RING_BYTES, MISC_OFF = LDSCTL_OFF + 320;
constexpr int LDS_BYTES = 147456;
enum { PH_PRO = 0, PH_L0 = 1, SP_NORM1 = 0, SP_INPROJ = 1, SP_MIX1 = 2, SP_MIX2 = 3, SP_OUTPROJ = 4, SP_NORM2 = 5, SP_GATEUP = 6, SP_DOWN = 7, NSP = 8, PH_FINAL = PH_L0 + DEPTH * NSP, NPHASE = PH_FINAL + 1 };

#ifndef REP_PH
#define REP_PH -1
#define REP_N 0
#define REP_MODE 0
#endif
struct Args { const float* in[19]; float* out; unsigned char* ws; int ph_lo, ph_hi, rep_ph, rep_n; };

__device__ __forceinline__ float wave_sum(float v) {
#pragma unroll
    for (int o = 1; o < 64; o <<= 1) v += __shfl_xor(v, o);
    return v;
}
__device__ __forceinline__ float bf2f(unsigned short u) { return __uint_as_float((unsigned)u << 16); }

template <class RowMap>
__device__ __forceinline__ void transpose_item(const float* W, int K, int N, bf16* WT, LAS float* scr, int kb, int nb, int lane, RowMap rowmap) {
    const int k0 = 64 * kb, n0 = 32 * nb, nn = n0 + (lane & 31);
#pragma unroll 8
    for (int i = 0; i < 32; ++i) { const int kk = 2 * i + (lane >> 5); scr[kk * 33 + (lane & 31)] = (nn < N) ? W[(size_t)(k0 + kk) * N + nn] : 0.f; }
    LDS_WAIT(); asm volatile("" ::: "memory");
    const int c = lane & 7;
#pragma unroll
    for (int j = 0; j < 4; ++j) { const int n = (lane >> 3) + 8 * j; const LAS float* s = scr + (8 * c) * 33 + n;
        v4u o; o.x = pk2(s[0 * 33], s[1 * 33]); o.y = pk2(s[2 * 33], s[3 * 33]); o.z = pk2(s[4 * 33], s[5 * 33]); o.w = pk2(s[6 * 33], s[7 * 33]);
        *(GAS v4u*)(WT + (size_t)rowmap(n0 + n) * K + k0 + 8 * c) = o; }
    LDS_WAIT(); asm volatile("" ::: "memory");
}
struct RowId { __device__ __forceinline__ int operator()(int n) const { return n; } };
struct RowGU { int up; __device__ __forceinline__ int operator()(int n) const { return (n >> 7) * 256 + up * 128 + (n & 127); } };

__device__ __forceinline__ void normmod_row_bf16(const float* xrow, const float* gain, const float* sh, const float* sc, bf16* orow, int lane) {
    const GAS f32x4* xr = (const GAS f32x4*)xrow + lane;
    f32x4 v[4]; float s = 0.f;
#pragma unroll
    for (int j = 0; j < 4; ++j) { v[j] = xr[64 * j]; s += (v[j].x * v[j].x + v[j].y * v[j].y) + (v[j].z * v[j].z + v[j].w * v[j].w); }
    const float rstd = rsqrtf(wave_sum(s) * (1.f / D_MODEL) + RMS_EPS);
    GAS unsigned long long* o8 = (GAS unsigned long long*)orow + lane;
#pragma unroll
    for (int j = 0; j < 4; ++j) {
        const f32x4 g = ((const GAS f32x4*)gain)[64 * j + lane], a = ((const GAS f32x4*)sc)[64 * j + lane], b = ((const GAS f32x4*)sh)[64 * j + lane];
        const f32x4 y = (v[j] * rstd * g) * (a + 1.0f) + b;
        o8[64 * j] = (unsigned long long)pk2(y.x, y.y) | ((unsigned long long)pk2(y.z, y.w) << 32);
    }
}
__device__ __forceinline__ void normmod_row_f32(const float* xrow, const float* gain, const float* sh, const float* sc, float* orow, int lane) {
    const GAS f32x4* xr = (const GAS f32x4*)xrow + lane;
    f32x4 v[4]; float s = 0.f;
#pragma unroll
    for (int j = 0; j < 4; ++j) { v[j] = xr[64 * j]; s += (v[j].x * v[j].x + v[j].y * v[j].y) + (v[j].z * v[j].z + v[j].w * v[j].w); }
    const float rstd = rsqrtf(wave_sum(s) * (1.f / D_MODEL) + RMS_EPS);
#pragma unroll
    for (int j = 0; j < 4; ++j) {
        const f32x4 g = ((const GAS f32x4*)gain)[64 * j + lane], a = ((const GAS f32x4*)sc)[64 * j + lane], b = ((const GAS f32x4*)sh)[64 * j + lane];
        ((GAS f32x4*)orow)[64 * j + lane] = (v[j] * rstd * g) * (a + 1.0f) + b;
    }
}

namespace att {
using bf16x8 = __attribute__((ext_vector_type(8))) short;
using s16x4 = __attribute__((ext_vector_type(4))) short;
using f32x16 = __attribute__((ext_vector_type(16))) float;
using u32x4 = __attribute__((ext_vector_type(4))) unsigned;
typedef __attribute__((address_space(3))) const char* lds_cptr;
typedef short v4i16_t __attribute__((ext_vector_type(4)));
typedef float f32x2_t __attribute__((ext_vector_type(2))); typedef __bf16 bf16x2_t __attribute__((ext_vector_type(2)));
constexpr int PITCH = NPROJ;
constexpr int NSLOT = 3, SLOTB = 16384, VOFF = 8192;
constexpr int LDS_OST = NSLOT * SLOTB;
constexpr int LDS_SB_BYTES = LDS_OST + 8 * 4096;
__device__ __forceinline__ int crow(int r, int hi) { return (r & 3) + 8 * (r >> 2) + 4 * hi; }
__device__ __forceinline__ void glds16(const void* gsrc, unsigned lds_dst) { unsigned keep;
    asm volatile("s_mov_b32 %0, m0\n\ts_mov_b32 m0, %2\n\ts_nop 0\n\tglobal_load_lds_dwordx4 %1, off\n\ts_mov_b32 m0, %0" : "=&s"(keep) : "v"(gsrc), "s"(lds_dst) : "memory"); }
__device__ __forceinline__ unsigned cvtpk(float lo, float hi) { f32x2_t v = {lo, hi}; bf16x2_t b = __builtin_convertvector(v, bf16x2_t); return __builtin_bit_cast(unsigned, b); }
__device__ __forceinline__ s16x4 vtr(lds_cptr p) { return __builtin_bit_cast(s16x4, __builtin_amdgcn_ds_read_tr16_b64_v4i16((__attribute__((address_space(3))) v4i16_t*)p)); }
#define ATT_WAIT_BAR(N) asm volatile("s_waitcnt vmcnt(" #N ") lgkmcnt(0)\n\ts_barrier" ::: "memory")

template <bool DIAG>
__device__ __forceinline__ void sb_tile(lds_cptr kp, lds_cptr vp, const bf16x8 (&qr)[4], f32x16 (&o)[2], float& carry, int dd, float f0) {
    f32x16 y[2];
#pragma unroll
    for (int d0 = 0; d0 < 4; ++d0) {
        const bf16x8 b0 = *(const __attribute__((address_space(3))) bf16x8*)(kp + d0 * 2048);
        const bf16x8 b1 = *(const __attribute__((address_space(3))) bf16x8*)(kp + d0 * 2048 + 512);
        if (d0 == 0) { const f32x16 z = {}; y[0] = __builtin_amdgcn_mfma_f32_32x32x16_bf16(b0, qr[0], z, 0, 0, 0); y[1] = __builtin_amdgcn_mfma_f32_32x32x16_bf16(b1, qr[0], z, 0, 0, 0); }
        else { y[0] = __builtin_amdgcn_mfma_f32_32x32x16_bf16(b0, qr[d0], y[0], 0, 0, 0); y[1] = __builtin_amdgcn_mfma_f32_32x32x16_bf16(b1, qr[d0], y[1], 0, 0, 0); }
    }
    f32x16 x[2];
#pragma unroll
    for (int p = 0; p < 2; ++p)
#pragma unroll
        for (int r = 0; r < 16; ++r) {
            float lg = __builtin_amdgcn_logf(1.0f + __builtin_amdgcn_exp2f(y[p][r]));
            if (DIAG) lg = (32 * p + (r & 3) + 8 * (r >> 2) < dd) ? lg : 0.f;
            x[p][r] = lg;
        }
#pragma unroll
    for (int p = 0; p < 2; ++p)
#pragma unroll
        for (int g = 0; g < 4; ++g) { x[p][4 * g + 2] += x[p][4 * g + 3]; x[p][4 * g + 1] += x[p][4 * g + 2]; x[p][4 * g] += x[p][4 * g + 1]; }
    float R = carry;
    u32x4 pw[4];
#pragma unroll
    for (int p = 1; p >= 0; --p)
#pragma unroll
        for (int g = 3; g >= 0; --g) {
            const float T = x[p][4 * g];
            const auto rr = __builtin_amdgcn_permlane32_swap(__float_as_uint(T), __float_as_uint(T), false, false);
            const float Tlo = __uint_as_float(rr[0]), Thi = __uint_as_float(rr[1]);
            const float off = __builtin_fmaf(Thi, f0, R);
            R += Tlo + Thi;
            float a[4];
#pragma unroll
            for (int i = 0; i < 4; ++i) {
                a[i] = __builtin_amdgcn_exp2f((y[p][4 * g + i] - x[p][4 * g + i]) - off);
                if (DIAG) a[i] = (32 * p + i + 8 * g < dd) ? a[i] : 0.f;
            }
            pw[2 * p + (g >> 1)][(g & 1) * 2 + 0] = cvtpk(a[0], a[1]);
            pw[2 * p + (g >> 1)][(g & 1) * 2 + 1] = cvtpk(a[2], a[3]);
        }
    carry = R;
#pragma unroll
    for (int d0 = 0; d0 < 2; ++d0)
#pragma unroll
        for (int ks = 0; ks < 4; ++ks) {
            const s16x4 lo = vtr(vp + d0 * 4096 + ks * 1024), hi4 = vtr(vp + d0 * 4096 + ks * 1024 + 512);
            const bf16x8 vf = {lo[0], lo[1], lo[2], lo[3], hi4[0], hi4[1], hi4[2], hi4[3]};
            o[d0] = __builtin_amdgcn_mfma_f32_32x32x16_bf16(__builtin_bit_cast(bf16x8, pw[ks]), vf, o[d0], 0, 0, 0);
        }
}

__device__ __forceinline__ void sb_unit(int b, int h, int qb, const bf16* PROJ, bf16* OSB, LAS unsigned char* shm, int tid) {
    const int lane = tid & 63, r32 = lane & 31, hi = lane >> 5; const int wid = __builtin_amdgcn_readfirstlane(tid >> 6);
    const long rowbase = (long)b * SEQ; const int t0w = qb * 256 + wid * 32;
    const bf16* Qw = PROJ + (rowbase + t0w) * PITCH + C_SBQ + h * 64;
    const bf16* Kh = PROJ + rowbase * PITCH + C_SBK + h * 64; const bf16* Vh = PROJ + rowbase * PITCH + C_SBV + h * 64;
    const unsigned lds0 = (unsigned)(unsigned long)shm;
    const bf16* ksrc = Kh + (long)lane * PITCH + wid * 8;
    const bf16* vsrc = Vh + (long)(16 * (wid & 3) + (lane >> 2)) * PITCH + (wid >> 2) * 32 + (lane & 3) * 8;
    const unsigned kdst = lds0 + wid * 1024, vdst = lds0 + VOFF + wid * 1024;
#define SB_DMA(t, slot) do { glds16(ksrc + (long)(t) * 64 * PITCH, (unsigned)__builtin_amdgcn_readfirstlane(kdst + (slot) * SLOTB)); \
                             glds16(vsrc + (long)(t) * 64 * PITCH, (unsigned)__builtin_amdgcn_readfirstlane(vdst + (slot) * SLOTB)); } while (0)
    const lds_cptr shm3 = (lds_cptr)shm;
    const lds_cptr kp0 = shm3 + hi * 1024 + r32 * 16;
    const lds_cptr vp0 = shm3 + VOFF + ((lane >> 4) & 1) * 32 + (lane & 3) * 8 + (4 * hi + ((lane & 15) >> 2)) * 64;
    const int NT = 4 * (qb + 1), jdiag = (8 * qb + wid) >> 1;
    SB_DMA(NT - 1, 0);
    bf16x8 qr[4];
#pragma unroll
    for (int d0 = 0; d0 < 4; ++d0) qr[d0] = *reinterpret_cast<const bf16x8*>(&Qw[(long)r32 * PITCH + d0 * 16 + hi * 8]);
    f32x16 o[2]; o[0] = f32x16{}; o[1] = f32x16{};
    float carry = 0.f; const float f0 = hi ? 0.f : 1.f; const int dd = 32 * (wid & 1) + r32 - 4 * hi;
    LAS int* done_at = (LAS int*)(shm + LDS_SB_BYTES);
    if (lane == 0) done_at[wid] = 0x7fffffff;
    bool done = false;
    int slot = 0;
    for (int it = 0; it < NT; ++it) {
        const int jt = NT - 1 - it; const int nslot = (slot == NSLOT - 1) ? 0 : slot + 1;
        if (it >= 2) { const int da = done_at[lane & 7]; if (__all(da < it - 1)) break; }
        if (it + 1 < NT) { SB_DMA(jt - 1, nslot); ATT_WAIT_BAR(2); } else { ATT_WAIT_BAR(0); }
        if (!done) {
            if (jt == jdiag) sb_tile<true>(kp0 + slot * SLOTB, vp0 + slot * SLOTB, qr, o, carry, dd, f0);
            else if (jt < jdiag) sb_tile<false>(kp0 + slot * SLOTB, vp0 + slot * SLOTB, qr, o, carry, dd, f0);
            if (jt <= jdiag && __all(carry > 134.0f)) { done = true; if (lane == 0) done_at[wid] = it; }
        }
        slot = nslot;
    }
#undef SB_DMA
    {   LAS unsigned short* stg = (LAS unsigned short*)(shm + LDS_OST + wid * 4096);
#pragma unroll
        for (int r = 0; r < 16; ++r) { const int orow = crow(r, hi);
#pragma unroll
            for (int d0 = 0; d0 < 2; ++d0) stg[orow * 64 + d0 * 32 + r32] = (unsigned short)f2bf(o[d0][r]); }
        asm volatile("s_waitcnt lgkmcnt(0)" ::: "memory");
        bf16* Ow = OSB + (rowbase + t0w) * 512 + h * 64;
#pragma unroll
        for (int i = 0; i < 4; ++i) { const int row = i * 8 + (lane >> 3), ch = lane & 7; const u32x4 v = *(const LAS u32x4*)(stg + row * 64 + ch * 8); *(u32x4*)(Ow + (long)row * 512 + ch * 8) = v; }
    }
    asm volatile("s_waitcnt lgkmcnt(0)\n\ts_barrier" ::: "memory");
}
}

namespace idx {
using att::bf16x8; using att::f32x16;
constexpr int PITCH = NPROJ;
#define IDX_DPP(v, ctrl) __builtin_amdgcn_update_dpp(0, (v), (ctrl), 0xF, 0xF, true)
__device__ __forceinline__ int wave_sum_i(int v) {
    v += IDX_DPP(v, 0xB1); v += IDX_DPP(v, 0x4E); v += IDX_DPP(v, 0x141); v += IDX_DPP(v, 0x140);
    return __builtin_amdgcn_readlane(v, 0) + __builtin_amdgcn_readlane(v, 16) + __builtin_amdgcn_readlane(v, 32) + __builtin_amdgcn_readlane(v, 48);
}
__device__ __forceinline__ unsigned umax_(unsigned a, unsigned b) { return a > b ? a : b; }
__device__ __forceinline__ unsigned umin_(unsigned a, unsigned b) { return a < b ? a : b; }
__device__ __forceinline__ unsigned wave_max_u(unsigned v) {
    v = umax_(v, (unsigned)IDX_DPP((int)v, 0xB1)); v = umax_(v, (unsigned)IDX_DPP((int)v, 0x4E)); v = umax_(v, (unsigned)IDX_DPP((int)v, 0x141)); v = umax_(v, (unsigned)IDX_DPP((int)v, 0x140));
    return umax_(umax_((unsigned)__builtin_amdgcn_readlane((int)v, 0), (unsigned)__builtin_amdgcn_readlane((int)v, 16)), umax_((unsigned)__builtin_amdgcn_readlane((int)v, 32), (unsigned)__builtin_amdgcn_readlane((int)v, 48)));
}
__device__ __forceinline__ unsigned wave_min_u(unsigned v) {
    v = umin_(v, (unsigned)IDX_DPP((int)v, 0xB1)); v = umin_(v, (unsigned)IDX_DPP((int)v, 0x4E)); v = umin_(v, (unsigned)IDX_DPP((int)v, 0x141)); v = umin_(v, (unsigned)IDX_DPP((int)v, 0x140));
    return umin_(umin_((unsigned)__builtin_amdgcn_readlane((int)v, 0), (unsigned)__builtin_amdgcn_readlane((int)v, 16)), umin_((unsigned)__builtin_amdgcn_readlane((int)v, 32), (unsigned)__builtin_amdgcn_readlane((int)v, 48)));
}
__device__ __forceinline__ unsigned f2key(float v) { unsigned u = __float_as_uint(v); u = (u == 0x80000000u) ? 0u : u; return (u & 0x80000000u) ? ~u : (u | 0x80000000u); }
__device__ __forceinline__ float key2f(unsigned k) { return __uint_as_float((k & 0x80000000u) ? (k & 0x7fffffffu) : ~k); }

__device__ __forceinline__ void idx_unit(int b, int tb, const bf16* PROJ, unsigned* MASK, LAS unsigned char* shm, int tid, bool skip_sel = false) {
    const int lane = tid & 63, r32 = lane & 31, hi = lane >> 5; const int wid = __builtin_amdgcn_readfirstlane(tid >> 6);
    const long rowbase = (long)b * SEQ; const int t0 = tb * 16;
    LAS float* sc = (LAS float*)shm;
    if (t0 + 15 >= 256) {
        bf16x8 A[2][4]; float wv[2][4][4];
#pragma unroll
        for (int mb = 0; mb < 2; ++mb) {
            const bf16* qrow = PROJ + (rowbase + t0 + 8 * mb + (r32 >> 2)) * PITCH + C_IQ + (r32 & 3) * 64 + 8 * hi;
#pragma unroll
            for (int ks = 0; ks < 4; ++ks) A[mb][ks] = *reinterpret_cast<const bf16x8*>(qrow + 16 * ks);
#pragma unroll
            for (int g = 0; g < 4; ++g) { const bf16* wrow = PROJ + (rowbase + t0 + 8 * mb + 2 * g + hi) * PITCH + C_IW;
#pragma unroll
                for (int hh = 0; hh < 4; ++hh) wv[mb][g][hh] = bf2f(wrow[hh]) * 0.0625f; }
        }
        const int nkb = ((t0 + 15) >> 5) + 1;
        for (int kb = wid; kb < nkb; kb += 8) {
            const int s = 32 * kb + r32;
            const bf16* krow = PROJ + (rowbase + s) * PITCH + C_IK + 8 * hi;
            bf16x8 B[4];
#pragma unroll
            for (int ks = 0; ks < 4; ++ks) B[ks] = *reinterpret_cast<const bf16x8*>(krow + 16 * ks);
#pragma unroll
            for (int mb = 0; mb < 2; ++mb) {
                f32x16 acc = {};
#pragma unroll
                for (int ks = 0; ks < 4; ++ks) acc = __builtin_amdgcn_mfma_f32_32x32x16_bf16(A[mb][ks], B[ks], acc, 0, 0, 0);
#pragma unroll
                for (int g = 0; g < 4; ++g) {
                    float v = 0.f;
#pragma unroll
                    for (int hh = 0; hh < 4; ++hh) v += fmaxf(acc[4 * g + hh], 0.f) * wv[mb][g][hh];
                    sc[(8 * mb + 2 * g + hi) * 2048 + s] = v;
                }
            }
        }
    }
    __syncthreads();
#pragma unroll 1
    for (int rr = 0; rr < (skip_sel ? 0 : 2); ++rr) {
        const int q = 2 * wid + rr, t = t0 + q;
        unsigned long long mybits = 0ull;
        if (t < 256) {
            if (lane < 32) { const int lo = 64 * lane; mybits = (lo + 63 <= t) ? ~0ull : ((lo > t) ? 0ull : ((1ull << (t - lo + 1)) - 1ull)); }
        } else {
            unsigned k[32];
            const int ng = (t >> 9) + 1;
            unsigned vmax = 0u, vmin = 0xffffffffu;
#pragma unroll
            for (int g = 0; g < 4; ++g) {
                if (g < ng) {
#pragma unroll
                    for (int i = 8 * g; i < 8 * g + 8; ++i) { const int s = 64 * i + lane; const unsigned kk = f2key(sc[q * 2048 + s]); k[i] = (s <= t) ? kk : 0u;
                        vmax = umax_(vmax, k[i]); vmin = umin_(vmin, k[i] ? k[i] : 0xffffffffu); }
                } else {
#pragma unroll
                    for (int i = 8 * g; i < 8 * g + 8; ++i) k[i] = 0u;
                }
            }
            unsigned lo_k = wave_min_u(vmin), hi_k = wave_max_u(vmax) + 1u;
            int c_lo = t + 1, c_hi = 0;
            for (int it = 0; hi_k - lo_k > 1u; ++it) {
                unsigned m = lo_k + ((hi_k - lo_k) >> 1);
                if (it < 12) { const unsigned mv = f2key(0.5f * (key2f(lo_k) + key2f(hi_k))); if (mv > lo_k && mv < hi_k) m = mv; }
                int c = 0;
#pragma unroll
                for (int g = 0; g < 4; ++g) if (g < ng) {
#pragma unroll
                    for (int i = 8 * g; i < 8 * g + 8; ++i) c += (k[i] >= m) ? 1 : 0;
                }
                c = wave_sum_i(c);
                if (c >= 256) { lo_k = m; c_lo = c; if (c == 256) break; } else { hi_k = m; c_hi = c; }
            }
            if (c_lo == 256) {
#pragma unroll
                for (int i = 0; i < 32; ++i) { const unsigned long long bal = __ballot(k[i] >= lo_k); if (lane == i) mybits = bal; }
            } else {
                int remaining = 256 - c_hi;
#pragma unroll
                for (int i = 0; i < 32; ++i) {
                    const unsigned long long gt = __ballot(k[i] > lo_k), eq = __ballot(k[i] == lo_k);
                    const int rank = (int)__builtin_amdgcn_mbcnt_hi((unsigned)(eq >> 32), __builtin_amdgcn_mbcnt_lo((unsigned)eq, 0u));
                    const unsigned long long take = __ballot((k[i] == lo_k) && (rank < remaining));
                    const int ne = __builtin_popcountll(eq); remaining -= (ne < remaining) ? ne : remaining;
                    if (lane == i) mybits = gt | take;
                }
            }
        }
        if (lane < 32) *(unsigned long long*)(MASK + (rowbase + t) * 64 + 2 * lane) = mybits;
    }
    __syncthreads();
}
#undef IDX_DPP

__device__ __forceinline__ void kvdec_unit(int u, const bf16* PROJ, const bf16* WKVT, bf16* KD, bf16* VD, LAS unsigned char* shm, int tid) {
    const int lane = tid & 63, r32 = lane & 31, hi = lane >> 5; const int wid = __builtin_amdgcn_readfirstlane(tid >> 6);
    const int mr = wid >> 2, nc = wid & 3; const long m0 = (long)u * 64 + 32 * mr;
    const bf16* arow = PROJ + (m0 + r32) * PITCH + C_KVL + 8 * hi;
    const bf16* brow = WKVT + (32 * nc + r32) * 256 + 8 * hi;
    f32x16 acc = {}; float ss = 0.f;
#pragma unroll
    for (int kc = 0; kc < 4; ++kc) {
        bf16x8 a[4], bb[4];
#pragma unroll
        for (int j = 0; j < 4; ++j) { a[j] = *reinterpret_cast<const bf16x8*>(arow + 16 * (4 * kc + j)); bb[j] = *reinterpret_cast<const bf16x8*>(brow + 16 * (4 * kc + j)); }
#pragma unroll
        for (int j = 0; j < 4; ++j) {
#pragma unroll
            for (int e = 0; e < 8; ++e) { const float f = bf2f((unsigned short)a[j][e]); ss += f * f; }
            acc = __builtin_amdgcn_mfma_f32_32x32x16_bf16(a[j], bb[j], acc, 0, 0, 0);
        }
    }
    { const auto rr = __builtin_amdgcn_permlane32_swap(__float_as_uint(ss), __float_as_uint(ss), false, false); ss = __uint_as_float(rr[0]) + __uint_as_float(rr[1]); }
    LAS float* rs = (LAS float*)(shm + wid * 128);
    if (hi == 0) rs[r32] = rsqrtf(ss * (1.f / KV_LORA) + RMS_EPS);
    asm volatile("s_waitcnt lgkmcnt(0)" ::: "memory");
    bf16* dst = (nc < 2 ? KD : VD) + (nc & 1) * 32 + r32;
#pragma unroll
    for (int r = 0; r < 16; ++r) { const int row = att::crow(r, hi); dst[(m0 + row) * 64] = (bf16)f2bf(acc[r] * rs[row]); }
    asm volatile("s_waitcnt lgkmcnt(0)" ::: "memory");
}
}

namespace att {
constexpr int DSA_OST = NSLOT * SLOTB;
constexpr int DSA_WSF = DSA_OST + 32768;
constexpr int DSA_MSK = DSA_WSF + 1024;
constexpr int DSA_LDS_BYTES = DSA_MSK + 32 * 264;
constexpr float DSA_THR = 8.0f;
__device__ __forceinline__ void dsa_tile(lds_cptr kp, lds_cptr vp, const bf16x8 (&qr)[4], f32x16 (&o)[2], float& m_run, float& l, unsigned long long mbits, float slope2, float bl, int hi, int r32,
                                         LAS float* wsf) {
    f32x16 y[2];
#pragma unroll
    for (int p = 0; p < 2; ++p)
#pragma unroll
        for (int r = 0; r < 16; ++r) y[p][r] = __builtin_fmaf(slope2, (float)(32 * p + (r & 3) + 8 * (r >> 2)), bl);
#pragma unroll
    for (int d0 = 0; d0 < 4; ++d0) {
        const bf16x8 b0 = *(const __attribute__((address_space(3))) bf16x8*)(kp + d0 * 2048);
        const bf16x8 b1 = *(const __attribute__((address_space(3))) bf16x8*)(kp + d0 * 2048 + 512);
        y[0] = __builtin_amdgcn_mfma_f32_32x32x16_bf16(b0, qr[d0], y[0], 0, 0, 0); y[1] = __builtin_amdgcn_mfma_f32_32x32x16_bf16(b1, qr[d0], y[1], 0, 0, 0);
    }
    const unsigned ninf = 0xff800000u;
    const int w0 = (int)((unsigned)mbits >> (4 * hi)), w1 = (int)((unsigned)(mbits >> 32) >> (4 * hi));
    float cm = -INFINITY;
#pragma unroll
    for (int p = 0; p < 2; ++p)
#pragma unroll
        for (int r = 0; r < 16; ++r) {
            const unsigned mm = (unsigned)__builtin_amdgcn_sbfe(p ? w1 : w0, (r & 3) + 8 * (r >> 2), 1);
            const float v = __uint_as_float((__float_as_uint(y[p][r]) & mm) | (ninf & ~mm));
            y[p][r] = v; cm = fmaxf(cm, v);
        }
    { const auto rr = __builtin_amdgcn_permlane32_swap(__float_as_uint(cm), __float_as_uint(cm), false, false); cm = fmaxf(__uint_as_float(rr[0]), __uint_as_float(rr[1])); }
    const bool need = cm > m_run + DSA_THR;
    if (__any(need)) {
        const float alpha = need ? __builtin_amdgcn_exp2f(m_run - cm) : 1.0f;
        m_run = need ? cm : m_run; l *= alpha;
        if (hi == 0) wsf[r32] = alpha;
#pragma unroll
        for (int r = 0; r < 16; ++r) { const float a = wsf[crow(r, hi)]; o[0][r] *= a; o[1][r] *= a; }
    }
    const float m_safe = (m_run == -INFINITY) ? 0.f : m_run;
    u32x4 pw[4]; float ls = 0.f;
#pragma unroll
    for (int p = 0; p < 2; ++p)
#pragma unroll
        for (int g = 0; g < 4; ++g) {
            float a[4];
#pragma unroll
            for (int i = 0; i < 4; ++i) { a[i] = __builtin_amdgcn_exp2f(y[p][4 * g + i] - m_safe); ls += a[i]; }
            pw[2 * p + (g >> 1)][(g & 1) * 2 + 0] = cvtpk(a[0], a[1]);
            pw[2 * p + (g >> 1)][(g & 1) * 2 + 1] = cvtpk(a[2], a[3]);
        }
    l += ls;
#pragma unroll
    for (int d0 = 0; d0 < 2; ++d0)
#pragma unroll
        for (int ks = 0; ks < 4; ++ks) {
            const s16x4 lo = vtr(vp + d0 * 4096 + ks * 1024), hi4 = vtr(vp + d0 * 4096 + ks * 1024 + 512);
            const bf16x8 vf = {lo[0], lo[1], lo[2], lo[3], hi4[0], hi4[1], hi4[2], hi4[3]};
            o[d0] = __builtin_amdgcn_mfma_f32_32x32x16_bf16(__builtin_bit_cast(bf16x8, pw[ks]), vf, o[d0], 0, 0, 0);
        }
}
__device__ __forceinline__ void norm_row_512(const u32x4 v, const float* gain, bf16* dst, int lane) {
    float f[8];
#pragma unroll
    for (int e = 0; e < 4; ++e) { f[2 * e] = __uint_as_float(v[e] << 16); f[2 * e + 1] = __uint_as_float(v[e] & 0xffff0000u); }
    float ss = 0.f;
#pragma unroll
    for (int e = 0; e < 8; ++e) ss += f[e] * f[e];
    const float rstd = rsqrtf(wave_sum(ss) * (1.f / 512.f) + RMS_EPS);
    const f32x4 g0 = *(const f32x4*)(gain + lane * 8), g1 = *(const f32x4*)(gain + lane * 8 + 4);
    u32x4 w; w.x = cvtpk(f[0] * rstd * g0.x, f[1] * rstd * g0.y); w.y = cvtpk(f[2] * rstd * g0.z, f[3] * rstd * g0.w); w.z = cvtpk(f[4] * rstd * g1.x, f[5] * rstd * g1.y); w.w = cvtpk(f[6] * rstd * g1.z, f[7] * rstd * g1.w);
    *(u32x4*)(dst + lane * 8) = w;
}
__device__ __forceinline__ void dsa_unit(int b, int qb32, const bf16* PROJ, const bf16* KD, const bf16* VD, const unsigned* MASK, const bf16* OSB, const float* gsb, const float* gdsa, bf16* OCAT,
                                         LAS unsigned char* shm, int tid) {
    const int lane = tid & 63, r32 = lane & 31, hi = lane >> 5; const int wid = __builtin_amdgcn_readfirstlane(tid >> 6);
    const long rowbase = (long)b * SEQ; const int t0 = qb32 * 32;
    const bf16* Qw = PROJ + (rowbase + t0) * PITCH + C_DQ + wid * 64;
    const unsigned lds0 = (unsigned)(unsigned long)shm;
    const bf16* ksrc = KD + (rowbase + lane) * 64 + wid * 8;
    const bf16* vsrc = VD + (rowbase + 16 * (wid & 3) + (lane >> 2)) * 64 + (wid >> 2) * 32 + (lane & 3) * 8;
    const unsigned kdst = lds0 + wid * 1024, vdst = lds0 + VOFF + wid * 1024;
#define DSA_DMA(t, slot) do { glds16(ksrc + (long)(t) * 64 * 64, (unsigned)__builtin_amdgcn_readfirstlane(kdst + (slot) * SLOTB)); \
                              glds16(vsrc + (long)(t) * 64 * 64, (unsigned)__builtin_amdgcn_readfirstlane(vdst + (slot) * SLOTB)); } while (0)
    const lds_cptr shm3 = (lds_cptr)shm;
    const lds_cptr kp0 = shm3 + hi * 1024 + r32 * 16;
    const lds_cptr vp0 = shm3 + VOFF + ((lane >> 4) & 1) * 32 + (lane & 3) * 8 + (4 * hi + ((lane & 15) >> 2)) * 64;
    LAS float* wsf = (LAS float*)(shm + DSA_WSF) + wid * 32;
    const int NT = (t0 >> 6) + 1;
    DSA_DMA(0, 0);
    bf16x8 qr[4];
#pragma unroll
    for (int d0 = 0; d0 < 4; ++d0) qr[d0] = *reinterpret_cast<const bf16x8*>(&Qw[(long)r32 * PITCH + d0 * 16 + hi * 8]);
    {   const int row = tid >> 4, ch = tid & 15; const u32x4 v = *(const u32x4*)(MASK + (rowbase + t0 + row) * 64 + ch * 4);
        LAS unsigned long long* d = (LAS unsigned long long*)(shm + DSA_MSK + row * 264 + ch * 16);
        d[0] = (unsigned long long)v.x | ((unsigned long long)v.y << 32); d[1] = (unsigned long long)v.z | ((unsigned long long)v.w << 32); }
    const LAS unsigned long long* mrow = (const LAS unsigned long long*)(shm + DSA_MSK + r32 * 264);
    const float slope2 = __builtin_amdgcn_exp2f(-(float)(wid + 1)) * LOG2E;
    float bl = -slope2 * (float)(t0 + r32 - 4 * hi);
    f32x16 o[2]; o[0] = f32x16{}; o[1] = f32x16{};
    float m_run = -INFINITY, l = 0.f;
    int slot = 0;
    for (int jt = 0; jt < NT; ++jt) {
        const int nslot = (slot == NSLOT - 1) ? 0 : slot + 1;
        if (jt + 1 < NT) { DSA_DMA(jt + 1, nslot); ATT_WAIT_BAR(2); } else { ATT_WAIT_BAR(0); }
        const unsigned long long mcur = mrow[jt];
        dsa_tile(kp0 + slot * SLOTB, vp0 + slot * SLOTB, qr, o, m_run, l, mcur, slope2, bl, hi, r32, wsf);
        bl += 64.0f * slope2; slot = nslot;
    }
#undef DSA_DMA
    { const auto rr = __builtin_amdgcn_permlane32_swap(__float_as_uint(l), __float_as_uint(l), false, false); l = __uint_as_float(rr[0]) + __uint_as_float(rr[1]); }
    if (hi == 0) wsf[r32] = __builtin_amdgcn_rcpf(l);
    LAS unsigned short* ost = (LAS unsigned short*)(shm + DSA_OST);
#pragma unroll
    for (int r = 0; r < 16; ++r) { const int row = crow(r, hi); const float rl = wsf[row];
#pragma unroll
        for (int d0 = 0; d0 < 2; ++d0) ost[row * 512 + wid * 64 + d0 * 32 + r32] = (unsigned short)f2bf(o[d0][r] * rl); }
    asm volatile("s_waitcnt lgkmcnt(0)\n\ts_barrier" ::: "memory");
#pragma unroll
    for (int i = 0; i < 4; ++i) {
        const int row = 4 * wid + i; const long m = rowbase + t0 + row;
        const u32x4 vd = *(const LAS u32x4*)(ost + row * 512 + lane * 8);
        const u32x4 vs = *(const u32x4*)(OSB + m * 512 + lane * 8);
        norm_row_512(vs, gsb, OCAT + m * 1024, lane);
        norm_row_512(vd, gdsa, OCAT + m * 1024 + 512, lane);
    }
    asm volatile("s_waitcnt lgkmcnt(0)\n\ts_barrier" ::: "memory");
}
}

__global__ void __launch_bounds__(NWAVES * 64, 2) mega(Args args) {
    extern __shared__ __attribute__((aligned(16))) unsigned char lds[];
    LAS unsigned char* L = (LAS unsigned char*)lds;
    volatile LAS unsigned* MISC = (volatile LAS unsigned*)(L + MISC_OFF);
    const int G = gridDim.x, bx = blockIdx.x;
    const int vcu = (G % 8 == 0) ? (bx % 8) * (G / 8) + bx / 8 : bx;
    unsigned char* ws = args.ws;
    gu32* ctl = (gu32*)(ws + WS_CTL);
    for (int u = threadIdx.x; u < (LDS_BYTES - LDSCTL_OFF) / 4; u += NWAVES * 64) ((LAS unsigned*)(L + LDSCTL_OFF))[u] = 0u;
    __syncthreads();
    XcdBarrier bar; bar.bar = (unsigned*)(ctl + CW_BAR); bar.x = 0; bar.st = nullptr;
    const bool multi = (args.ph_hi - args.ph_lo) > 1;
    if (multi) bar = xcd_barrier_post((unsigned*)(ctl + CW_BAR), MISC + 8);

    float* mod0 = (float*)(ws + WS_MOD); float* modf = mod0 + 2 * 8 * 6144;
    bf16* XN = (bf16*)(ws + WS_XN); bf16* PROJ = (bf16*)(ws + WS_PROJ); bf16* OCAT = (bf16*)(ws + WS_OCAT);
    const int NGW = G * NWAVES;

    int rep_left = args.rep_n; bool first = true;
    for (int ph = args.ph_lo; ph < args.ph_hi; (ph == args.rep_ph && rep_left > 0) ? --rep_left : ++ph) {
        if (!first) xcd_barrier(bar);
        first = false;
        int tid = threadIdx.x; asm volatile("" : "+v"(tid));
        const int lane = tid & 63, wave = __builtin_amdgcn_readfirstlane(tid >> 6), gw = vcu * NWAVES + wave;
        if (ph == PH_PRO) {
            LAS float* scr = (LAS float*)(L + RING_OFF + wave * 8448);
            constexpr int I_IN = 16 * 88, I_O = 16 * 32, I_G = 16 * 88, I_D = 44 * 32, I_LAYER = I_IN + I_O + 2 * I_G + I_D;
            for (int it = gw; it < DEPTH * I_LAYER; it += NGW) {
                const int l = it / I_LAYER; int r = it % I_LAYER;
                if (r < I_IN) { transpose_item(args.in[6] + (size_t)l * 1024 * IN_COLS, 1024, IN_COLS, (bf16*)(ws + WS_WIN + l * WIN_BYTES), scr, r / 88, r % 88, lane, RowId{}); continue; } r -= I_IN;
                if (r < I_O) { transpose_item(args.in[12] + (size_t)l * 1024 * 1024, 1024, 1024, (bf16*)(ws + WS_WO + l * WO_BYTES), scr, r / 32, r % 32, lane, RowId{}); continue; } r -= I_O;
                if (r < I_G) { transpose_item(args.in[13] + (size_t)l * 1024 * D_FF, 1024, D_FF, (bf16*)(ws + WS_WGU + l * WGU_BYTES), scr, r / 88, r % 88, lane, RowGU{0}); continue; } r -= I_G;
                if (r < I_G) { transpose_item(args.in[14] + (size_t)l * 1024 * D_FF, 1024, D_FF, (bf16*)(ws + WS_WGU + l * WGU_BYTES), scr, r / 88, r % 88, lane, RowGU{1}); continue; } r -= I_G;
                transpose_item(args.in[15] + (size_t)l * D_FF * 1024, D_FF, 1024, (bf16*)(ws + WS_WD + l * WD_BYTES), scr, r / 32, r % 32, lane, RowId{});
            }
            for (int i = gw * 64 + lane; i < DEPTH * 128 * 256; i += NGW * 64) { const int ll = i >> 15, n = (i >> 8) & 127, j = i & 255;
                const float w = (n < 64) ? args.in[8][(size_t)ll * 256 * 64 + j * 64 + n] : args.in[9][(size_t)ll * 256 * 64 + j * 64 + (n - 64)];
                ((bf16*)(ws + WS_WKV))[i] = (bf16)f2bf(w * args.in[7][ll * 256 + j]); }
            __syncthreads();
            LAS float* cact = (LAS float*)(L + 0);
            LAS float* red = (LAS float*)(L + 32768);
            for (int i = tid; i < 8192; i += NWAVES * 64) { const float v = args.in[1][i]; cact[i] = v / (1.f + __expf(-v)); }
            __syncthreads();
            constexpr int NIT = (2 * 6144 + 2048) / 64;
            for (int it = vcu; it < NIT; it += G) {
                const float* W; const float* bias; float* outp; int N, n0;
                if (it < 96) { W = args.in[2]; bias = args.in[3]; outp = mod0; N = 6144; n0 = it * 64; }
                else if (it < 192) { W = args.in[2] + (size_t)1024 * 6144; bias = args.in[3] + 6144; outp = mod0 + 8 * 6144; N = 6144; n0 = (it - 96) * 64; }
                else { W = args.in[16]; bias = args.in[17]; outp = modf; N = 2048; n0 = (it - 192) * 64; }
                float acc[8];
#pragma unroll
                for (int b = 0; b < 8; ++b) acc[b] = 0.f;
                const float* wp = W + (size_t)(wave * 128) * N + n0 + lane;
#pragma unroll 4
                for (int k = 0; k < 128; ++k) { const float w = wp[(size_t)k * N];
#pragma unroll
                    for (int b = 0; b < 8; ++b) acc[b] += cact[b * 1024 + wave * 128 + k] * w; }
#pragma unroll
                for (int b = 0; b < 8; ++b) red[(wave * 8 + b) * 64 + lane] = acc[b];
                __syncthreads();
                { const int b = wave; float s = 0.f;
#pragma unroll
                  for (int w = 0; w < 8; ++w) s += red[(w * 8 + b) * 64 + lane];
                  outp[(size_t)b * N + n0 + lane] = s + bias[n0 + lane]; }
                __syncthreads();
            }
        } else if (ph == PH_FINAL) {
            for (int m = gw; m < M; m += NGW) { const int b = m / SEQ; normmod_row_f32(args.out + (size_t)m * D_MODEL, args.in[18], modf + (size_t)b * 2048, modf + (size_t)b * 2048 + 1024, args.out + (size_t)m * D_MODEL, lane); }
        } else {
            const int l = (ph - PH_L0) / NSP, sp = (ph - PH_L0) % NSP;
            const float* mod = mod0 + (size_t)l * 8 * 6144;
            if (sp == SP_NORM1 || sp == SP_NORM2) {
                const float* xin = (sp == SP_NORM1 && l == 0) ? args.in[0] : args.out;
                const float* gain = (sp == SP_NORM1 ? args.in[4] : args.in[5]) + l * 1024;
                const int o = (sp == SP_NORM1) ? 0 : 3072;
                for (int m = gw; m < M; m += NGW) { const int b = m / SEQ; normmod_row_bf16(xin + (size_t)m * D_MODEL, gain, mod + (size_t)b * 6144 + o, mod + (size_t)b * 6144 + o + 1024, XN + (size_t)m * D_MODEL, lane); }
            } else if (sp == SP_INPROJ) {
                pg8::Gemm g{XN, (const bf16*)(ws + WS_WIN + l * WIN_BYTES), M, NPROJ, 1024}; pg8::StaticOrder S; S.init(M, NPROJ, G, bx);
                pg8::EpiProj E{PROJ, NPROJ, C2};
                pg8::gemm_phase<pg8::EpiProj, pg8::StaticOrder, true, true>(L + RING_OFF, g, S, E, tid);
            } else if (sp == SP_OUTPROJ) {
                pg8::Gemm g{OCAT, (const bf16*)(ws + WS_WO + l * WO_BYTES), M, 1024, 1024}; pg8::StaticOrder S; S.init(M, 1024, G, bx);
                pg8::EpiResid E{l == 0 ? args.in[0] : args.out, args.out, 1024, mod + 2048, 6144};
                pg8::gemm_phase<pg8::EpiResid, pg8::StaticOrder, true, true>(L + RING_OFF, g, S, E, tid);
            } else if (sp == SP_GATEUP) {
                pg8::Gemm g{XN, (const bf16*)(ws + WS_WGU + l * WGU_BYTES), M, NGU, 1024}; pg8::StaticOrder S; S.init(M, NGU, G, bx);
                pg8::EpiSwiGLU E{PROJ, D_FF};
                pg8::gemm_phase<pg8::EpiSwiGLU, pg8::StaticOrder, true, true>(L + RING_OFF, g, S, E, tid);
            } else if (sp == SP_DOWN) {
                pg8::Gemm g{PROJ, (const bf16*)(ws + WS_WD + l * WD_BYTES), M, 1024, D_FF}; pg8::StaticOrder S; S.init(M, 1024, G, bx);
                pg8::EpiResid E{args.out, args.out, 1024, mod + 5120, 6144};
                pg8::gemm_phase<pg8::EpiResid, pg8::StaticOrder, true, true>(L + RING_OFF, g, S, E, tid);
            }
            else if (sp == SP_MIX1 && !(REP_MODE >= 2 && ph == args.rep_ph && rep_left < args.rep_n)) {
                for (int u = vcu; u < 512; u += G) { const int pi = u & 255, bh = pi >> 2, p = pi & 3, qb = (u >> 8) ? 7 - p : p;
                    att::sb_unit(bh >> 3, bh & 7, qb, PROJ, (bf16*)(ws + WS_OSB), L + RING_OFF, tid); }
            }
            if (sp == SP_MIX1 && !(REP_MODE == 1 && ph == args.rep_ph && rep_left < args.rep_n)) {
                for (int u = vcu; u < 1024; u += G) { const int k = u >> 8, v = u & 255, bb = v >> 5, j = v & 31; const int tb = (k == 0) ? j : (k == 1) ? 63 - j : (k == 2) ? 64 + j : 127 - j;
                    idx::idx_unit(bb, tb, PROJ, (unsigned*)(ws + WS_MASK), L + RING_OFF, tid, REP_MODE == 3 && ph == args.rep_ph && rep_left < args.rep_n); }
                for (int u = vcu; u < 256; u += G) idx::kvdec_unit(u, PROJ, (const bf16*)(ws + WS_WKV) + (size_t)l * 128 * 256, (bf16*)(ws + WS_KD), (bf16*)(ws + WS_VD), L + RING_OFF, tid);
            }
            if (sp == SP_MIX2) {
                for (int u = vcu; u < 512; u += G) { const int v = u & 255, bb = v >> 5, j = v & 31, qb32 = (u >> 8) ? 63 - j : j;
                    att::dsa_unit(bb, qb32, PROJ, (const bf16*)(ws + WS_KD), (const bf16*)(ws + WS_VD), (const unsigned*)(ws + WS_MASK), (const bf16*)(ws + WS_OSB),
                                  args.in[10] + l * 512, args.in[11] + l * 512, OCAT, L + RING_OFF, tid); }
            }
        }
    }
}

__global__ void __launch_bounds__(256) k_sb_attn_bf(const bf16* __restrict__ proj, bf16* __restrict__ osb) {
    __shared__ float qs[4][64];
    const int tid = threadIdx.x, lane = tid & 63, w = tid >> 6;
    const int wv = blockIdx.x * 4 + w;
    const int t = wv % SEQ, bh = wv / SEQ, h = bh % 8, b = bh / 8;
    const size_t mrow = (size_t)b * SEQ;
    qs[w][lane] = bf2f(proj[(mrow + t) * NPROJ + C_SBQ + h * 64 + lane]);
    __syncthreads();
    float carry = 0.f, o = 0.f;
    for (int s_hi = t - 1; s_hi >= 0; s_hi -= 64) {
        const int s = s_hi - lane; const bool valid = s >= 0;
        float y = 0.f;
        if (valid) { const bf16* kr = proj + (mrow + s) * NPROJ + C_SBK + h * 64; float d = 0.f;
#pragma unroll
            for (int i = 0; i < 64; ++i) d += qs[w][i] * bf2f(kr[i]);
            y = d; }
        const float lg = fmaxf(y, 0.f) + log2f(1.f + exp2f(-fabsf(y)));
        const float Lb = valid ? -lg : 0.f;
        float incl = Lb;
#pragma unroll
        for (int off = 1; off < 64; off <<= 1) { const float n = __shfl_up(incl, off); if (lane >= off) incl += n; }
        const float tail = carry + (incl - Lb);
        const float Aw = valid ? exp2f((y - lg) + tail) : 0.f;
        carry += __shfl(incl, 63);
        const int nvalid = (s_hi + 1 < 64) ? s_hi + 1 : 64;
        for (int j = 0; j < nvalid; ++j) { const float a = __shfl(Aw, j); o += a * bf2f(proj[(mrow + (s_hi - j)) * NPROJ + C_SBV + h * 64 + lane]); }
    }
    osb[(mrow + t) * 512 + h * 64 + lane] = (bf16)f2bf(o);
}
__global__ void __launch_bounds__(256) k_idx_bf(const bf16* __restrict__ proj, unsigned* __restrict__ mask) {
    __shared__ float qi[256];
    __shared__ float wi[4];
    __shared__ float score[SEQ];
    const int m = blockIdx.x, t = m % SEQ, b = m / SEQ, tid = threadIdx.x, lane = tid & 63;
    const size_t mrow = (size_t)b * SEQ;
    qi[tid] = bf2f(proj[(size_t)m * NPROJ + C_IQ + tid]);
    if (tid < 4) wi[tid] = bf2f(proj[(size_t)m * NPROJ + C_IW + tid]) * 0.5f;
    __syncthreads();
    const int n = t + 1;
    for (int s = tid; s < n; s += 256) {
        const bf16* kr = proj + (mrow + s) * NPROJ + C_IK;
        float d[4] = {0.f, 0.f, 0.f, 0.f};
#pragma unroll 8
        for (int i = 0; i < 64; ++i) { const float kv = bf2f(kr[i]);
#pragma unroll
            for (int hh = 0; hh < 4; ++hh) d[hh] += qi[hh * 64 + i] * kv; }
        float sc = 0.f;
#pragma unroll
        for (int hh = 0; hh < 4; ++hh) sc += fmaxf(d[hh] * 0.125f, 0.f) * wi[hh];
        score[s] = sc;
    }
    __syncthreads();
    for (int base = 0; base < SEQ; base += 256) {
        const int s = base + tid; bool sel = false;
        if (s < n) {
            if (n <= 256) sel = true;
            else { const float v = score[s]; int rank = 0;
                for (int j = 0; j < n; ++j) { const float u = score[j]; rank += (u > v || (u == v && j < s)) ? 1 : 0; }
                sel = rank < 256; }
        }
        const unsigned long long bal = __ballot(sel);
        if (lane == 0) { mask[(size_t)m * 64 + (s >> 5)] = (unsigned)bal; mask[(size_t)m * 64 + (s >> 5) + 1] = (unsigned)(bal >> 32); }
    }
}
__global__ void k_kvdec_bf(const bf16* __restrict__ proj, const float* __restrict__ kvg, const float* __restrict__ wuk, const float* __restrict__ wuv, bf16* __restrict__ kd, bf16* __restrict__ vd) {
    __shared__ float kvn[256];
    __shared__ float red[2];
    const int m = blockIdx.x, tid = threadIdx.x;
    const bf16* row = proj + (size_t)m * NPROJ + C_KVL;
    const float a = bf2f(row[tid]), b = bf2f(row[tid + 128]);
    float ss = a * a + b * b;
    for (int o = 32; o > 0; o >>= 1) ss += __shfl_xor(ss, o);
    if ((tid & 63) == 0) red[tid >> 6] = ss;
    __syncthreads();
    const float rstd = rsqrtf((red[0] + red[1]) * (1.f / KV_LORA) + RMS_EPS);
    kvn[tid] = a * rstd * kvg[tid]; kvn[tid + 128] = b * rstd * kvg[tid + 128];
    __syncthreads();
    const float* w = (tid < 64) ? wuk : wuv; const int n = tid & 63;
    float acc = 0.f;
    for (int j = 0; j < 256; ++j) acc += kvn[j] * w[j * 64 + n];
    if (tid < 64) kd[(size_t)m * 64 + n] = (bf16)f2bf(acc); else vd[(size_t)m * 64 + n] = (bf16)f2bf(acc);
}
__global__ void __launch_bounds__(256) k_dsa_bf(const bf16* __restrict__ proj, const bf16* __restrict__ kd, const bf16* __restrict__ vd, const unsigned* __restrict__ mask, bf16* __restrict__ odsa) {
    __shared__ float qs[4][64];
    const int tid = threadIdx.x, lane = tid & 63, w = tid >> 6;
    const int wv = blockIdx.x * 4 + w;
    const int h = wv % 8, m = wv / 8, t = m % SEQ, b = m / SEQ;
    const size_t mrow = (size_t)b * SEQ;
    qs[w][lane] = bf2f(proj[(size_t)m * NPROJ + C_DQ + h * 64 + lane]);
    __syncthreads();
    const float slope = exp2f(-(float)(h + 1)) * LOG2E;
    float mrun = -INFINITY, l = 0.f, o = 0.f;
    for (int s0 = 0; s0 <= t; s0 += 64) {
        const unsigned w0 = mask[(size_t)m * 64 + (s0 >> 5)], w1 = mask[(size_t)m * 64 + (s0 >> 5) + 1];
        const unsigned long long bits = ((unsigned long long)w1 << 32) | w0;
        if (bits == 0ull) continue;
        const int s = s0 + lane; const bool sel = (bits >> lane) & 1ull;
        float logit = -INFINITY;
        if (sel) { const bf16* kr = kd + (mrow + s) * 64; float d = 0.f;
#pragma unroll
            for (int i = 0; i < 64; ++i) d += qs[w][i] * bf2f(kr[i]);
            logit = d - slope * (float)(t - s); }
        float cmax = logit;
        for (int off = 32; off > 0; off >>= 1) cmax = fmaxf(cmax, __shfl_xor(cmax, off));
        const float nm = fmaxf(mrun, cmax);
        const float alpha = exp2f(mrun - nm);
        const float p = sel ? exp2f(logit - nm) : 0.f;
        float ps = p;
        for (int off = 32; off > 0; off >>= 1) ps += __shfl_xor(ps, off);
        l = l * alpha + ps; o *= alpha; mrun = nm;
        for (int j = 0; j < 64; ++j) if ((bits >> j) & 1ull) { const float pj = __shfl(p, j); o += pj * bf2f(vd[(mrow + s0 + j) * 64 + lane]); }
    }
    odsa[(size_t)m * 512 + h * 64 + lane] = (bf16)f2bf(o / l);
}
__global__ void k_outnorm_bf(const bf16* __restrict__ osb, const bf16* __restrict__ odsa, const float* __restrict__ gsb, const float* __restrict__ gdsa, bf16* __restrict__ ocat) {
    __shared__ float red[4];
    const int m = blockIdx.x, tid = threadIdx.x;
    const bf16* src = (tid < 128) ? osb + (size_t)m * 512 + tid * 4 : odsa + (size_t)m * 512 + (tid - 128) * 4;
    float v[4]; float ss = 0.f;
#pragma unroll
    for (int j = 0; j < 4; ++j) { v[j] = bf2f(src[j]); ss += v[j] * v[j]; }
    for (int o = 32; o > 0; o >>= 1) ss += __shfl_xor(ss, o);
    if ((tid & 63) == 0) red[tid >> 6] = ss;
    __syncthreads();
    const float tot = (tid < 128) ? (red[0] + red[1]) : (red[2] + red[3]);
    const float rstd = rsqrtf(tot * (1.f / 512.f) + RMS_EPS);
    const float* g = (tid < 128) ? gsb + tid * 4 : gdsa + (tid - 128) * 4;
#pragma unroll
    for (int j = 0; j < 4; ++j) ocat[(size_t)m * 1024 + tid * 4 + j] = (bf16)f2bf(v[j] * rstd * g[j]);
}

extern "C" void kernel_launch(void* const* d_in, const int* in_sizes, int n_in, void* d_out, int out_size, void* d_ws, size_t ws_size, hipStream_t stream) {
    static int grid = 0;
    if (grid == 0) {
        if (n_in != 19 || out_size != M * D_MODEL || ws_size < WS_END) { fprintf(stderr, "kernel_launch: unexpected problem shape (n_in %d out %d ws %zu)\n", n_in, out_size, ws_size); grid = -1; return; }
        int dev = 0, cus = 0;
        if (hipGetDevice(&dev) != hipSuccess || hipDeviceGetAttribute(&cus, hipDeviceAttributeMultiprocessorCount, dev) != hipSuccess) { grid = -1; return; }
        if (hipFuncSetAttribute((const void*)mega, hipFuncAttributeMaxDynamicSharedMemorySize, LDS_BYTES) != hipSuccess) { fprintf(stderr, "kernel_launch: hipFuncSetAttribute failed\n"); grid = -1; return; }
        (void)hipGetLastError();
        grid = cus;
    }
    if (grid < 0) return;
    (void)hipMemsetAsync((char*)d_ws + WS_CTL, 0, CTL_ZERO_BYTES, stream);
    Args a{};
    for (int i = 0; i < 19; ++i) a.in[i] = (const float*)d_in[i];
    a.out = (float*)d_out; a.ws = (unsigned char*)d_ws;
    char* ws = (char*)d_ws;
    const bf16* PROJ = (const bf16*)(ws + WS_PROJ);
    auto run = [&](int lo, int hi) { a.ph_lo = lo; a.ph_hi = hi; hipLaunchKernelGGL(mega, dim3(grid), dim3(NWAVES * 64), LDS_BYTES, stream, a); };
    a.rep_ph = REP_PH; a.rep_n = REP_N;
    (void)PROJ; run(PH_PRO, NPHASE);
}
```

```cpp
#include <hip/hip_runtime.h>
#include <cstdio>
#include <cstdint>
#include <cmath>
#include <type_traits>
namespace pg8 {
#define PG8_LAS __attribute__((address_space(3)))
typedef unsigned short bf16_t;
typedef short bf16x8 __attribute__((ext_vector_type(8)));
typedef float f32x4 __attribute__((ext_vector_type(4)));
typedef unsigned u32x4 __attribute__((ext_vector_type(4)));
constexpr int BM = 256, BK = 64, HALF = 128, HTB = HALF * BK * 2  , STAGE_BYTES = 8 * HTB, NXCD = 8, WGM = 8;

__host__ __device__ __forceinline__ int lds_byte(int r, int c) { const int st = (r >> 4) * 2 + (c >> 5), rr = r & 15, cc = c & 31, ob = rr * 64 + cc * 2; return st * 1024 + (ob ^ (((ob >> 9) & 1) << 5)); }
__host__ __device__ __forceinline__ void stage_rc(int b, int& R, int& C) { const int st = b / 1024, sb = b % 1024, swz = sb ^ (((sb >> 9) & 1) << 5); R = (st >> 1) * 16 + swz / 64; C = (st & 1) * 32 + (swz % 64) / 2; }
__host__ __device__ __forceinline__ int perm32(int rho) { const int n = rho >> 4, i = rho & 15; return 8 * (i >> 2) + 4 * n + (i & 3); }

struct Unit { int pm, pn; };
struct Gemm { const bf16_t* A; const bf16_t* Bt; int M, N, K; };

struct StaticOrder {
    int nM, nN, nwg, G, c;
    __host__ __device__ void init(int M, int N, int G_, int c_) { nM = M / BM; nN = N / BM; nwg = nM * nN; G = G_; c = c_; }
    __host__ __device__ bool next(int i, Unit& u) const {
        const long L = (long)i * G + c; if (L >= nwg) return false;
        int wgid = (int)L; { const int q = nwg / NXCD, r = nwg % NXCD, xcd = wgid % NXCD, off = wgid / NXCD; wgid = (xcd < r ? xcd * (q + 1) : r * (q + 1) + (xcd - r) * q) + off; }
        const int nig = WGM * nN, gid = wgid / nig, fm = gid * WGM, gsz = (nM - fm) < WGM ? (nM - fm) : WGM;
        u.pm = fm + ((wgid % nig) % gsz); u.pn = (wgid % nig) / gsz; return true;
    }
    __device__ __forceinline__ void a_ready(const Unit&) const {}
    __device__ __forceinline__ void done(const Unit&) const {}
};

__device__ __forceinline__ unsigned cvt_pk_bf16(float lo, float hi) { unsigned r; asm volatile("v_cvt_pk_bf16_f32 %0, %1, %2" : "=v"(r) : "v"(lo), "v"(hi)); return r; }
typedef float f32x2 __attribute__((ext_vector_type(2)));
__device__ __forceinline__ float silu_f(float g) { return g * __builtin_amdgcn_rcpf(1.0f + __builtin_amdgcn_exp2f(-1.4426950408889634f * g)); }
struct EpiProj {
    static constexpr bool PERM = true, AFTER_DRAIN = false;
    bf16_t* O; int ldc; float qscale;
    __device__ __forceinline__ void operator()(const f32x4 (&acc)[2][2][4][2], const Unit& u, int wr, int wc, int fr, int fq) const {
        const int row0 = u.pm * BM + wr * 64 + fr, col0 = u.pn * BM + wc * 32 + 8 * fq;
        const float sc = (u.pn < 2 || u.pn == 6 || u.pn == 7) ? qscale : 1.0f;
#pragma unroll
        for (int ai = 0; ai < 2; ++ai)
#pragma unroll
            for (int m = 0; m < 4; ++m) { bf16_t* rowp = O + (size_t)(row0 + ai * HALF + m * 16) * ldc + col0;
#pragma unroll
                for (int bj = 0; bj < 2; ++bj) { const f32x4 v0 = acc[ai][bj][m][0] * sc, v1 = acc[ai][bj][m][1] * sc;
                    u32x4 w; w.x = cvt_pk_bf16(v0[0], v0[1]); w.y = cvt_pk_bf16(v0[2], v0[3]); w.z = cvt_pk_bf16(v1[0], v1[1]); w.w = cvt_pk_bf16(v1[2], v1[3]);
                    *(u32x4*)(rowp + bj * HALF) = w; } }
    }
};
struct EpiSwiGLU {
    static constexpr bool PERM = true, AFTER_DRAIN = false;
    bf16_t* Hb; int ldh;
    __device__ __forceinline__ void operator()(const f32x4 (&acc)[2][2][4][2], const Unit& u, int wr, int wc, int fr, int fq) const {
        const int row0 = u.pm * BM + wr * 64 + fr, col0 = u.pn * HALF + wc * 32 + 8 * fq;
#pragma unroll
        for (int ai = 0; ai < 2; ++ai)
#pragma unroll
            for (int m = 0; m < 4; ++m) { bf16_t* rowp = Hb + (size_t)(row0 + ai * HALF + m * 16) * ldh + col0;
                const f32x4 g0 = acc[ai][0][m][0], g1 = acc[ai][0][m][1], u0 = acc[ai][1][m][0], u1 = acc[ai][1][m][1];
                u32x4 w;
                w.x = cvt_pk_bf16(silu_f(g0[0]) * u0[0], silu_f(g0[1]) * u0[1]); w.y = cvt_pk_bf16(silu_f(g0[2]) * u0[2], silu_f(g0[3]) * u0[3]);
                w.z = cvt_pk_bf16(silu_f(g1[0]) * u1[0], silu_f(g1[1]) * u1[1]); w.w = cvt_pk_bf16(silu_f(g1[2]) * u1[2], silu_f(g1[3]) * u1[3]);
                *(u32x4*)rowp = w; }
    }
};
struct EpiResid {
    static constexpr bool PERM = false, AFTER_DRAIN = false;
    const float* R; float* out; int ldc; const float* gate; int gstride;
    __device__ __forceinline__ void operator()(const f32x4 (&acc)[2][2][4][2], const Unit& u, int wr, int wc, int fr, int fq) const {
        const int col0 = u.pn * BM + wc * 32 + 4 * fq; const float* gb = gate + (size_t)(u.pm >> 3) * gstride;
        f32x4 gv[2][2];
#pragma unroll
        for (int bj = 0; bj < 2; ++bj)
#pragma unroll
            for (int n = 0; n < 2; ++n) gv[bj][n] = *(const f32x4*)(gb + col0 + bj * HALF + n * 16);
#pragma unroll
        for (int ai = 0; ai < 2; ++ai)
#pragma unroll
            for (int m = 0; m < 4; ++m) { const size_t off = (size_t)(u.pm * BM + ai * HALF + wr * 64 + m * 16 + fr) * ldc + col0;
#pragma unroll
                for (int bj = 0; bj < 2; ++bj)
#pragma unroll
                    for (int n = 0; n < 2; ++n) { const f32x4 r = *(const f32x4*)(R + off + bj * HALF + n * 16); *(f32x4*)(out + off + bj * HALF + n * 16) = r + gv[bj][n] * acc[ai][bj][m][n]; } }
    }
};
template <class Epi, class Sched, bool ALIGN_EPI = false, bool SP2 = false>
__device__ __forceinline__ void gemm_phase(PG8_LAS unsigned char* lds, const Gemm g, const Sched& S, const Epi& E, const int tid) {
    const int wid = __builtin_amdgcn_readfirstlane(tid >> 6), lane = tid & 63, wr = wid >> 2, wc = wid & 3, fr = lane & 15, fq = lane >> 4;
    const int K = g.K, nt = K / BK;
    unsigned voffA[2], voffB[2];
#pragma unroll
    for (int i = 0; i < 2; ++i) { int R, C; stage_rc(tid * 16 + i * 8192, R, C); const int Rb = Epi::PERM ? ((R & ~31) + perm32(R & 31)) : R;
        voffA[i] = (unsigned)(R * K + C) * 2u; voffB[i] = (unsigned)(Rb * K + C) * 2u; }
    const size_t kstep = (size_t)(BK * 2);
    const size_t hstep = (size_t)HALF * K * 2;
    const size_t tstep = 2 * hstep;
    const unsigned ldsw = (unsigned)wid * 1024u;
    const int aoff = lds_byte(wr * 64 + fr, fq * 8), boff = lds_byte(wc * 32 + fr, fq * 8);
#define PG8_SA(b, h) (((b) * 2 + (h)) * HTB)
#define PG8_SB(b, h) ((4 + (b) * 2 + (h)) * HTB)
#define PG8_STAGE(bufoff, gbase, voff) do { _Pragma("unroll") for (int _i = 0; _i < 2; ++_i) \
        __builtin_amdgcn_global_load_lds((const unsigned*)((const char*)(gbase) + (voff)[_i]), (PG8_LAS unsigned*)(lds + (bufoff) + ldsw + _i * 8192), 16, 0, 0); } while (0)
#define PG8_LDA(dst, b, h) do { _Pragma("unroll") for (int m = 0; m < 4; ++m) _Pragma("unroll") for (int k = 0; k < 2; ++k) dst[m][k] = *(const PG8_LAS bf16x8*)(lds + PG8_SA(b, h) + aoff + m * 2048 + k * 1024); } while (0)
#define PG8_LDB(dst, b, h) do { _Pragma("unroll") for (int n = 0; n < 2; ++n) _Pragma("unroll") for (int k = 0; k < 2; ++k) dst[n][k] = *(const PG8_LAS bf16x8*)(lds + PG8_SB(b, h) + boff + n * 2048 + k * 1024); } while (0)
#define PG8_MMA(ai, bj, At, Bt) do { __builtin_amdgcn_s_setprio(1); _Pragma("unroll") for (int m = 0; m < 4; ++m) _Pragma("unroll") for (int n = 0; n < 2; ++n) _Pragma("unroll") for (int k = 0; k < 2; ++k) \
        acc[ai][bj][m][n] = __builtin_amdgcn_mfma_f32_16x16x32_bf16(Bt[n][k], At[m][k], acc[ai][bj][m][n], 0, 0, 0); __builtin_amdgcn_s_setprio(0); } while (0)
#define PG8_WAIT_V(n) asm volatile("s_waitcnt vmcnt(" #n ")" ::: "memory")
#define PG8_WAIT_L(n) asm volatile("s_waitcnt lgkmcnt(" #n ")" ::: "memory")
#define PG8_BAR __builtin_amdgcn_s_barrier()
#define PG8_SCHED __builtin_amdgcn_sched_barrier(0)
    Unit cur, nxt; int ui = 0;
    if (!S.next(0, cur)) return;
    f32x4 acc[2][2][4][2];
#pragma unroll
    for (int a = 0; a < 2; ++a)
#pragma unroll
        for (int b = 0; b < 2; ++b)
#pragma unroll
            for (int m = 0; m < 4; ++m)
#pragma unroll
                for (int n = 0; n < 2; ++n) acc[a][b][m][n] = (f32x4){0.f, 0.f, 0.f, 0.f};
    bf16x8 At[4][2], B0[2][2], B1[2][2];
    const char* cA = (const char*)g.A + (size_t)cur.pm * tstep; const char* cB = (const char*)g.Bt + (size_t)cur.pn * tstep;
    S.a_ready(cur);
    if constexpr (SP2) {
        PG8_STAGE(PG8_SB(0, 0), cB, voffB); PG8_STAGE(PG8_SB(0, 1), cB + hstep, voffB); PG8_STAGE(PG8_SA(0, 0), cA, voffA); PG8_STAGE(PG8_SA(0, 1), cA + hstep, voffA);
        if (wr == 1) PG8_BAR;
        PG8_WAIT_V(2); PG8_BAR;
        PG8_STAGE(PG8_SB(1, 0), cB + kstep, voffB); PG8_STAGE(PG8_SA(1, 0), cA + kstep, voffA); PG8_STAGE(PG8_SB(1, 1), cB + hstep + kstep, voffB);
        PG8_WAIT_V(6); PG8_BAR;
    } else {
        PG8_STAGE(PG8_SB(0, 0), cB, voffB); PG8_STAGE(PG8_SA(0, 0), cA, voffA); PG8_STAGE(PG8_SB(0, 1), cB + hstep, voffB); PG8_STAGE(PG8_SA(0, 1), cA + hstep, voffA);
        if (wr == 1) PG8_BAR;
        PG8_WAIT_V(4); PG8_BAR;
        PG8_STAGE(PG8_SB(1, 0), cB + kstep, voffB); PG8_STAGE(PG8_SA(1, 0), cA + kstep, voffA); PG8_STAGE(PG8_SB(1, 1), cB + hstep + kstep, voffB);
        PG8_WAIT_V(6); PG8_BAR;
    }
    for (;;) {
        const bool has_next = S.next(ui + 1, nxt);
        const char* nA = has_next ? (const char*)g.A + (size_t)nxt.pm * tstep : cA; const char* nB = has_next ? (const char*)g.Bt + (size_t)nxt.pn * tstep : cB;
        for (int t = 0; t < nt; t += 2) {
            const bool last = (t == nt - 2);
            const char* a1 = cA + (size_t)(t + 1) * kstep;
            const char* a2 = last ? nA : cA + (size_t)(t + 2) * kstep; const char* b2 = last ? nB : cB + (size_t)(t + 2) * kstep;
            const char* a3 = a2 + kstep; const char* b3 = b2 + kstep;
            if (last && has_next) S.a_ready(nxt);
            if constexpr (SP2) {
            PG8_LDB(B0, 0, 0); PG8_LDB(B1, 0, 1); PG8_SCHED; PG8_LDA(At, 0, 0); PG8_STAGE(PG8_SA(1, 1), a1 + hstep, voffA);
            PG8_WAIT_V(8); PG8_WAIT_L(0); PG8_BAR; PG8_MMA(0, 0, At, B0); PG8_MMA(0, 1, At, B1); PG8_BAR; PG8_SCHED;
            PG8_LDA(At, 0, 1); PG8_STAGE(PG8_SB(0, 0), b2, voffB); PG8_STAGE(PG8_SB(0, 1), b2 + hstep, voffB); PG8_STAGE(PG8_SA(0, 0), a2, voffA);
            PG8_WAIT_V(8); PG8_WAIT_L(0); PG8_BAR; PG8_MMA(1, 0, At, B0); PG8_MMA(1, 1, At, B1); PG8_BAR; PG8_SCHED;
            PG8_LDB(B0, 1, 0); PG8_LDB(B1, 1, 1); PG8_SCHED; PG8_LDA(At, 1, 0); PG8_STAGE(PG8_SA(0, 1), a2 + hstep, voffA);
            PG8_WAIT_V(8); PG8_WAIT_L(0); PG8_BAR; PG8_MMA(0, 0, At, B0); PG8_MMA(0, 1, At, B1); PG8_BAR; PG8_SCHED;
            PG8_LDA(At, 1, 1); PG8_STAGE(PG8_SB(1, 0), b3, voffB); PG8_STAGE(PG8_SB(1, 1), b3 + hstep, voffB); PG8_STAGE(PG8_SA(1, 0), a3, voffA);
            PG8_WAIT_V(8); PG8_WAIT_L(0); PG8_BAR; PG8_MMA(1, 0, At, B0); PG8_MMA(1, 1, At, B1); PG8_BAR; PG8_SCHED;
            } else {
            PG8_LDB(B0, 0, 0); PG8_SCHED; PG8_LDA(At, 0, 0); PG8_STAGE(PG8_SA(1, 1), a1 + hstep, voffA);
            PG8_WAIT_L(8); PG8_BAR; PG8_WAIT_L(0); PG8_MMA(0, 0, At, B0); PG8_BAR; PG8_SCHED;
            PG8_LDB(B1, 0, 1); PG8_STAGE(PG8_SB(0, 0), b2, voffB);
            PG8_BAR; PG8_WAIT_L(0); PG8_MMA(0, 1, At, B1); PG8_BAR;
            PG8_LDA(At, 0, 1); PG8_STAGE(PG8_SA(0, 0), a2, voffA);
            PG8_BAR; PG8_WAIT_L(0); PG8_MMA(1, 0, At, B0); PG8_BAR; PG8_SCHED;
            PG8_STAGE(PG8_SB(0, 1), b2 + hstep, voffB);
            PG8_WAIT_V(6); PG8_BAR; PG8_MMA(1, 1, At, B1); PG8_BAR;
            PG8_LDB(B0, 1, 0); PG8_SCHED; PG8_LDA(At, 1, 0); PG8_STAGE(PG8_SA(0, 1), a2 + hstep, voffA);
            PG8_WAIT_L(8); PG8_BAR; PG8_WAIT_L(0); PG8_MMA(0, 0, At, B0); PG8_BAR; PG8_SCHED;
            PG8_LDB(B1, 1, 1); PG8_STAGE(PG8_SB(1, 0), b3, voffB);
            PG8_BAR; PG8_WAIT_L(0); PG8_MMA(0, 1, At, B1); PG8_BAR;
            PG8_LDA(At, 1, 1); PG8_STAGE(PG8_SA(1, 0), a3, voffA);
            PG8_BAR; PG8_WAIT_L(0); PG8_MMA(1, 0, At, B0); PG8_BAR; PG8_SCHED;
            PG8_STAGE(PG8_SB(1, 1), b3 + hstep, voffB);
            PG8_WAIT_V(6); PG8_BAR; PG8_MMA(1, 1, At, B1); PG8_BAR;
            }
        }
        if constexpr (ALIGN_EPI) { if (wr == 0) PG8_BAR; }
        if constexpr (!Epi::AFTER_DRAIN) { E(acc, cur, wr, wc, fr, fq); S.done(cur); }
        if (!has_next) break;
#pragma unroll
        for (int a = 0; a < 2; ++a)
#pragma unroll
            for (int b = 0; b < 2; ++b)
#pragma unroll
                for (int m = 0; m < 4; ++m)
#pragma unroll
                    for (int n = 0; n < 2; ++n) acc[a][b][m][n] = (f32x4){0.f, 0.f, 0.f, 0.f};
        cur = nxt; cA = nA; cB = nB; ++ui;
        if constexpr (ALIGN_EPI) { if (wr == 1) PG8_BAR; }
    }
    PG8_WAIT_V(0);
    if constexpr (!ALIGN_EPI) { if (wr == 0) PG8_BAR; }
    PG8_BAR;
    if constexpr (Epi::AFTER_DRAIN) { E.fused(acc, cur, wr, wc, fr, fq, lds, wid, lane); S.done(cur); }
#undef PG8_SA
#undef PG8_SB
#undef PG8_STAGE
#undef PG8_LDA
#undef PG8_LDB
#undef PG8_MMA
#undef PG8_WAIT_V
#undef PG8_WAIT_L
#undef PG8_BAR
#undef PG8_SCHED
}
}

#define GAS __attribute__((address_space(1)))
#define LAS __attribute__((address_space(3)))
typedef unsigned short bf16;
typedef unsigned v4u __attribute__((ext_vector_type(4)));
typedef float f32x4 __attribute__((ext_vector_type(4)));
typedef short bf16x8 __attribute__((ext_vector_type(8)));
typedef GAS unsigned gu32;
typedef GAS unsigned long long gu64;
#define RLX_AGENT __ATOMIC_RELAXED, __HIP_MEMORY_SCOPE_AGENT
#define LDS_WAIT() asm volatile("s_waitcnt lgkmcnt(0)" ::: "memory")
#define VM_WAIT() asm volatile("s_waitcnt vmcnt(0)" ::: "memory")
__device__ __forceinline__ unsigned long long rt() { return __builtin_amdgcn_s_memrealtime(); }
__device__ __forceinline__ unsigned f2bf(float f) { unsigned u = __builtin_bit_cast(unsigned, f); return (u + 0x7fffu + ((u >> 16) & 1u)) >> 16; }
__device__ __forceinline__ unsigned pk2(float lo, float hi) { return f2bf(lo) | (f2bf(hi) << 16); }

#define XB_TMO      128
#define XB_XCNT(j)  (256  + 64 * (j))
#define XB_XSUB(j)  (1280 + 64 * (j))
#define XB_XGEN(j)  (2304 + 64 * (j))
#define XB_TOP      3328
#define XB_TOPGEN   3392
#define XCD_BAR_WORDS 3456
#define XB_SPIN_CAP (1u << 18)

__device__ __forceinline__ unsigned xb_ld(unsigned* p)              { return __hip_atomic_load(p, __ATOMIC_RELAXED, __HIP_MEMORY_SCOPE_AGENT); }
__device__ __forceinline__ unsigned xb_add(unsigned* p, unsigned v) { return __hip_atomic_fetch_add(p, v, __ATOMIC_RELAXED, __HIP_MEMORY_SCOPE_AGENT); }
__device__ __forceinline__ unsigned xb_xcc_id() { return (unsigned)__builtin_amdgcn_s_getreg((3 << 11) | 20) & 0xFu; }
#define XB_SPIN(cond, bar) do { unsigned _sp = 0; while (cond) { __builtin_amdgcn_s_sleep(1); \
    if ((++_sp & 255u) == 0u) { if (xb_ld(&(bar)[XB_TMO])) break; if (_sp > XB_SPIN_CAP) { atomicAdd(&(bar)[XB_TMO], 1u); break; } } } } while (0)

struct XcdBarrier {
    unsigned* bar; unsigned x;
    volatile LAS unsigned* st;
};

__device__ __forceinline__ XcdBarrier xcd_barrier_post(unsigned* bar, volatile LAS unsigned* st) {
    XcdBarrier b; b.bar = bar; b.x = xb_xcc_id(); b.st = st;
    if (threadIdx.x == 0) (void)xb_add(&bar[XB_XCNT(b.x)], 1u);
    return b;
}
__device__ __forceinline__ void xcd_barrier_complete(unsigned* bar, unsigned x, unsigned& nloc, unsigned& nx) {
    const unsigned G = gridDim.x * gridDim.y * gridDim.z;
    unsigned sum, cnt, mine, sp = 0u;
    for (;;) {
        sum = 0u; cnt = 0u; mine = 0u;
#pragma unroll
        for (unsigned j = 0; j < 16; ++j) { const unsigned c = xb_ld(&bar[XB_XCNT(j)]); sum += c; cnt += (c > 0u) ? 1u : 0u; mine = (j == x) ? c : mine; }
        if (sum == G) break;
        __builtin_amdgcn_s_sleep(1);
        if ((++sp & 255u) == 0u) { if (xb_ld(&bar[XB_TMO])) break; if (sp > XB_SPIN_CAP) { atomicAdd(&bar[XB_TMO], 1u); break; } }
    }
    nloc = mine > 0u ? mine : 1u; nx = cnt > 0u ? cnt : 1u;
}

__device__ __forceinline__ void xcd_barrier(const XcdBarrier& b) {
    asm volatile("s_waitcnt vmcnt(0)" ::: "memory");
    __syncthreads();
    if (threadIdx.x == 0) {
        unsigned* bar = b.bar;
        __builtin_amdgcn_s_waitcnt(0);
        unsigned nloc = b.st[0], nx = b.st[1];
        if (nloc == 0u) { xcd_barrier_complete(bar, b.x, nloc, nx); b.st[0] = nloc; b.st[1] = nx; }
        const unsigned old = xb_add(&bar[XB_XSUB(b.x)], 1u);
        const unsigned gen = old / nloc;
        if (old + 1u == (gen + 1u) * nloc) {
            __builtin_amdgcn_fence(__ATOMIC_RELEASE, "agent");
            asm volatile("s_waitcnt vmcnt(0)" ::: "memory");
            const unsigned og = xb_add(&bar[XB_TOP], 1u);
            const unsigned tg = og / nx;
            if (og + 1u == (tg + 1u) * nx) xb_add(&bar[XB_TOPGEN], 1u);
            else XB_SPIN(xb_ld(&bar[XB_TOPGEN]) == tg, bar);
            __builtin_amdgcn_fence(__ATOMIC_ACQUIRE, "agent");
            xb_add(&bar[XB_XGEN(b.x)], 1u);
            asm volatile("s_waitcnt vmcnt(0)" ::: "memory");
        } else {
            XB_SPIN(xb_ld(&bar[XB_XGEN(b.x)]) == gen, bar);
            __builtin_amdgcn_fence(__ATOMIC_ACQUIRE, "agent");
            asm volatile("s_waitcnt vmcnt(0)" ::: "memory");
        }
    }
    __syncthreads();
}

constexpr int NWAVES = 8;
constexpr int D_MODEL = 1024, BATCH = 8, SEQ = 2048, DEPTH = 2, M = BATCH * SEQ;
constexpr int IN_COLS = 2628, NPROJ = 2816, D_FF = 2816, NGU = 2 * D_FF, KV_LORA = 256;
constexpr int C_SBQ = 0, C_SBK = 512, C_SBV = 1024, C_DQ = 1536, C_KVL = 2048, C_IQ = 2304, C_IK = 2560, C_IW = 2624;
constexpr float RMS_EPS = 1e-6f;
constexpr float LOG2E = 1.4426950408889634f;
constexpr float C2 = 0.125f * LOG2E;
constexpr size_t MiB = 1u << 20;
constexpr size_t WS_CTL = 0, CTL_ZERO_BYTES = 1 * MiB;
constexpr size_t WS_MOD = 1 * MiB;
constexpr size_t WS_WKV = 1 * MiB + 512 * 1024;
constexpr size_t WS_WIN = 2 * MiB, WIN_BYTES = (size_t)NPROJ * 1024 * 2;
constexpr size_t WS_WO = 13 * MiB, WO_BYTES = (size_t)1024 * 1024 * 2;
constexpr size_t WS_WGU = 17 * MiB, WGU_BYTES = (size_t)NGU * 1024 * 2;
constexpr size_t WS_WD = 39 * MiB, WD_BYTES = (size_t)1024 * D_FF * 2;
constexpr size_t WS_XN = 50 * MiB;
constexpr size_t WS_PROJ = 82 * MiB;
constexpr size_t WS_OSB = 170 * MiB;
constexpr size_t WS_OCAT = 186 * MiB;
constexpr size_t WS_KD = 218 * MiB, WS_VD = 220 * MiB;
constexpr size_t WS_MASK = 222 * MiB;
constexpr size_t WS_ODSA = 226 * MiB;
constexpr size_t WS_END = 242 * MiB;
constexpr int CW_BAR = 4096;
constexpr int RING_OFF = 0, RING_BYTES = 131072;
constexpr int LDSCTL_OFF = RING_BYTES, MISC_OFF = LDSCTL_OFF + 320;
constexpr int LDS_BYTES = 155648;
enum { PH_PRO = 0, PH_L0 = 1, SP_NORM1 = 0, SP_INPROJ = 1, SP_MIX1 = 2, SP_MIX2 = 3, SP_OUTPROJ = 4, SP_NORM2 = 5, SP_GATEUP = 6, SP_DOWN = 7, NSP = 8, PH_FINAL = PH_L0 + DEPTH * NSP, NPHASE = PH_FINAL + 1 };

#ifndef REP_PH
#define REP_PH -1
#define REP_N 0
#define REP_MODE 0
#endif
struct Args { const float* in[19]; float* out; unsigned char* ws; int ph_lo, ph_hi, rep_ph, rep_n; };

__device__ __forceinline__ float wave_sum(float v) {
#pragma unroll
    for (int o = 1; o < 64; o <<= 1) v += __shfl_xor(v, o);
    return v;
}
__device__ __forceinline__ float bf2f(unsigned short u) { return __uint_as_float((unsigned)u << 16); }

template <class RowMap>
__device__ __forceinline__ void transpose_item(const float* W, int K, int N, bf16* WT, LAS float* scr, int kb, int nb, int lane, RowMap rowmap) {
    const int k0 = 64 * kb, n0 = 32 * nb, nn = n0 + (lane & 31);
#pragma unroll 8
    for (int i = 0; i < 32; ++i) { const int kk = 2 * i + (lane >> 5); scr[kk * 33 + (lane & 31)] = (nn < N) ? W[(size_t)(k0 + kk) * N + nn] : 0.f; }
    LDS_WAIT(); asm volatile("" ::: "memory");
    const int c = lane & 7;
#pragma unroll
    for (int j = 0; j < 4; ++j) { const int n = (lane >> 3) + 8 * j; const LAS float* s = scr + (8 * c) * 33 + n;
        v4u o; o.x = pk2(s[0 * 33], s[1 * 33]); o.y = pk2(s[2 * 33], s[3 * 33]); o.z = pk2(s[4 * 33], s[5 * 33]); o.w = pk2(s[6 * 33], s[7 * 33]);
        *(GAS v4u*)(WT + (size_t)rowmap(n0 + n) * K + k0 + 8 * c) = o; }
    LDS_WAIT(); asm volatile("" ::: "memory");
}
struct RowId { __device__ __forceinline__ int operator()(int n) const { return n; } };
struct RowGU { int up; __device__ __forceinline__ int operator()(int n) const { return (n >> 7) * 256 + up * 128 + (n & 127); } };

__device__ __forceinline__ void normmod_row_bf16(const float* xrow, const float* gain, const float* sh, const float* sc, bf16* orow, int lane) {
    const GAS f32x4* xr = (const GAS f32x4*)xrow + lane;
    f32x4 v[4]; float s = 0.f;
#pragma unroll
    for (int j = 0; j < 4; ++j) { v[j] = xr[64 * j]; s += (v[j].x * v[j].x + v[j].y * v[j].y) + (v[j].z * v[j].z + v[j].w * v[j].w); }
    const float rstd = rsqrtf(wave_sum(s) * (1.f / D_MODEL) + RMS_EPS);
    GAS unsigned long long* o8 = (GAS unsigned long long*)orow + lane;
#pragma unroll
    for (int j = 0; j < 4; ++j) {
        const f32x4 g = ((const GAS f32x4*)gain)[64 * j + lane], a = ((const GAS f32x4*)sc)[64 * j + lane], b = ((const GAS f32x4*)sh)[64 * j + lane];
        const f32x4 y = (v[j] * rstd * g) * (a + 1.0f) + b;
        o8[64 * j] = (unsigned long long)pk2(y.x, y.y) | ((unsigned long long)pk2(y.z, y.w) << 32);
    }
}
__device__ __forceinline__ void normmod_row_f32(const float* xrow, const float* gain, const float* sh, const float* sc, float* orow, int lane, float post = 1.0f) {
    const GAS f32x4* xr = (const GAS f32x4*)xrow + lane;
    f32x4 v[4]; float s = 0.f;
#pragma unroll
    for (int j = 0; j < 4; ++j) { v[j] = xr[64 * j]; s += (v[j].x * v[j].x + v[j].y * v[j].y) + (v[j].z * v[j].z + v[j].w * v[j].w); }
    const float rstd = rsqrtf(wave_sum(s) * (1.f / D_MODEL) + RMS_EPS);
#pragma unroll
    for (int j = 0; j < 4; ++j) {
        const f32x4 g = ((const GAS f32x4*)gain)[64 * j + lane], a = ((const GAS f32x4*)sc)[64 * j + lane], b = ((const GAS f32x4*)sh)[64 * j + lane];
        ((GAS f32x4*)orow)[64 * j + lane] = ((v[j] * rstd * g) * (a + 1.0f) + b) * post;
    }
}

namespace att {
using bf16x8 = __attribute__((ext_vector_type(8))) short;
using s16x4 = __attribute__((ext_vector_type(4))) short;
using f32x16 = __attribute__((ext_vector_type(16))) float;
using u32x4 = __attribute__((ext_vector_type(4))) unsigned;
typedef __attribute__((address_space(3))) const char* lds_cptr;
typedef short v4i16_t __attribute__((ext_vector_type(4)));
typedef float f32x2_t __attribute__((ext_vector_type(2))); typedef __bf16 bf16x2_t __attribute__((ext_vector_type(2)));
constexpr int PITCH = NPROJ;
constexpr int NSLOT = 3, SLOTB = 16384, VOFF = 8192;
constexpr int LDS_OST = NSLOT * SLOTB;
constexpr int LDS_SB_BYTES = LDS_OST + 8 * 4096;
__device__ __forceinline__ int crow(int r, int hi) { return (r & 3) + 8 * (r >> 2) + 4 * hi; }
__device__ __forceinline__ void glds16(const void* gsrc, unsigned lds_dst) { unsigned keep;
    asm volatile("s_mov_b32 %0, m0\n\ts_mov_b32 m0, %2\n\ts_nop 0\n\tglobal_load_lds_dwordx4 %1, off\n\ts_mov_b32 m0, %0" : "=&s"(keep) : "v"(gsrc), "s"(lds_dst) : "memory"); }
__device__ __forceinline__ unsigned cvtpk(float lo, float hi) { f32x2_t v = {lo, hi}; bf16x2_t b = __builtin_convertvector(v, bf16x2_t); return __builtin_bit_cast(unsigned, b); }
__device__ __forceinline__ s16x4 vtr(lds_cptr p) { return __builtin_bit_cast(s16x4, __builtin_amdgcn_ds_read_tr16_b64_v4i16((__attribute__((address_space(3))) v4i16_t*)p)); }
#define ATT_WAIT_BAR(N) asm volatile("s_waitcnt vmcnt(" #N ") lgkmcnt(0)\n\ts_barrier" ::: "memory")

template <bool DIAG>
__device__ __forceinline__ void sb_tile(lds_cptr kp, lds_cptr vp, const bf16x8 (&qr)[4], f32x16 (&o)[2], float& carry, int dd, float f0) {
    f32x16 y[2];
#pragma unroll
    for (int d0 = 0; d0 < 4; ++d0) {
        const bf16x8 b0 = *(const __attribute__((address_space(3))) bf16x8*)(kp + d0 * 2048);
        const bf16x8 b1 = *(const __attribute__((address_space(3))) bf16x8*)(kp + d0 * 2048 + 512);
        if (d0 == 0) { const f32x16 z = {}; y[0] = __builtin_amdgcn_mfma_f32_32x32x16_bf16(b0, qr[0], z, 0, 0, 0); y[1] = __builtin_amdgcn_mfma_f32_32x32x16_bf16(b1, qr[0], z, 0, 0, 0); }
        else { y[0] = __builtin_amdgcn_mfma_f32_32x32x16_bf16(b0, qr[d0], y[0], 0, 0, 0); y[1] = __builtin_amdgcn_mfma_f32_32x32x16_bf16(b1, qr[d0], y[1], 0, 0, 0); }
    }
    f32x16 x[2];
#pragma unroll
    for (int p = 0; p < 2; ++p)
#pragma unroll
        for (int r = 0; r < 16; ++r) {
            float lg = __builtin_amdgcn_logf(1.0f + __builtin_amdgcn_exp2f(y[p][r]));
            if (DIAG) lg = (32 * p + (r & 3) + 8 * (r >> 2) < dd) ? lg : 0.f;
            x[p][r] = lg;
        }
#pragma unroll
    for (int p = 0; p < 2; ++p)
#pragma unroll
        for (int g = 0; g < 4; ++g) { x[p][4 * g + 2] += x[p][4 * g + 3]; x[p][4 * g + 1] += x[p][4 * g + 2]; x[p][4 * g] += x[p][4 * g + 1]; }
    float R = carry;
    u32x4 pw[4];
#pragma unroll
    for (int p = 1; p >= 0; --p)
#pragma unroll
        for (int g = 3; g >= 0; --g) {
            const float T = x[p][4 * g];
            const auto rr = __builtin_amdgcn_permlane32_swap(__float_as_uint(T), __float_as_uint(T), false, false);
            const float Tlo = __uint_as_float(rr[0]), Thi = __uint_as_float(rr[1]);
            const float off = __builtin_fmaf(Thi, f0, R);
            R += Tlo + Thi;
            float a[4];
#pragma unroll
            for (int i = 0; i < 4; ++i) {
                a[i] = __builtin_amdgcn_exp2f((y[p][4 * g + i] - x[p][4 * g + i]) - off);
                if (DIAG) a[i] = (32 * p + i + 8 * g < dd) ? a[i] : 0.f;
            }
            pw[2 * p + (g >> 1)][(g & 1) * 2 + 0] = cvtpk(a[0], a[1]);
            pw[2 * p + (g >> 1)][(g & 1) * 2 + 1] = cvtpk(a[2], a[3]);
        }
    carry = R;
#pragma unroll
    for (int d0 = 0; d0 < 2; ++d0)
#pragma unroll
        for (int ks = 0; ks < 4; ++ks) {
            const s16x4 lo = vtr(vp + d0 * 4096 + ks * 1024), hi4 = vtr(vp + d0 * 4096 + ks * 1024 + 512);
            const bf16x8 vf = {lo[0], lo[1], lo[2], lo[3], hi4[0], hi4[1], hi4[2], hi4[3]};
            o[d0] = __builtin_amdgcn_mfma_f32_32x32x16_bf16(__builtin_bit_cast(bf16x8, pw[ks]), vf, o[d0], 0, 0, 0);
        }
}

__device__ __forceinline__ void sb_unit(int b, int h, int qb, const bf16* PROJ, bf16* OSB, LAS unsigned char* shm, int tid) {
    const int lane = tid & 63, r32 = lane & 31, hi = lane >> 5; const int wid = __builtin_amdgcn_readfirstlane(tid >> 6);
    const long rowbase = (long)b * SEQ; const int t0w = qb * 256 + wid * 32;
    const bf16* Qw = PROJ + (rowbase + t0w) * PITCH + C_SBQ + h * 64;
    const bf16* Kh = PROJ + rowbase * PITCH + C_SBK + h * 64; const bf16* Vh = PROJ + rowbase * PITCH + C_SBV + h * 64;
    const unsigned lds0 = (unsigned)(unsigned long)shm;
    const bf16* ksrc = Kh + (long)lane * PITCH + wid * 8;
    const bf16* vsrc = Vh + (long)(16 * (wid & 3) + (lane >> 2)) * PITCH + (wid >> 2) * 32 + (lane & 3) * 8;
    const unsigned kdst = lds0 + wid * 1024, vdst = lds0 + VOFF + wid * 1024;
#define SB_DMA(t, slot) do { glds16(ksrc + (long)(t) * 64 * PITCH, (unsigned)__builtin_amdgcn_readfirstlane(kdst + (slot) * SLOTB)); \
                             glds16(vsrc + (long)(t) * 64 * PITCH, (unsigned)__builtin_amdgcn_readfirstlane(vdst + (slot) * SLOTB)); } while (0)
    const lds_cptr shm3 = (lds_cptr)shm;
    const lds_cptr kp0 = shm3 + hi * 1024 + r32 * 16;
    const lds_cptr vp0 = shm3 + VOFF + ((lane >> 4) & 1) * 32 + (lane & 3) * 8 + (4 * hi + ((lane & 15) >> 2)) * 64;
    const int NT = 4 * (qb + 1), jdiag = (8 * qb + wid) >> 1;
    SB_DMA(NT - 1, 0);
    bf16x8 qr[4];
#pragma unroll
    for (int d0 = 0; d0 < 4; ++d0) qr[d0] = *reinterpret_cast<const bf16x8*>(&Qw[(long)r32 * PITCH + d0 * 16 + hi * 8]);
    f32x16 o[2]; o[0] = f32x16{}; o[1] = f32x16{};
    float carry = 0.f; const float f0 = hi ? 0.f : 1.f; const int dd = 32 * (wid & 1) + r32 - 4 * hi;
    LAS int* done_at = (LAS int*)(shm + LDS_SB_BYTES);
    if (lane == 0) done_at[wid] = 0x7fffffff;
    bool done = false;
    int slot = 0;
    for (int it = 0; it < NT; ++it) {
        const int jt = NT - 1 - it; const int nslot = (slot == NSLOT - 1) ? 0 : slot + 1;
        if (it >= 2) { const int da = done_at[lane & 7]; if (__all(da < it - 1)) break; }
        if (it + 1 < NT) { SB_DMA(jt - 1, nslot); ATT_WAIT_BAR(2); } else { ATT_WAIT_BAR(0); }
        if (!done) {
            if (jt == jdiag) sb_tile<true>(kp0 + slot * SLOTB, vp0 + slot * SLOTB, qr, o, carry, dd, f0);
            else if (jt < jdiag) sb_tile<false>(kp0 + slot * SLOTB, vp0 + slot * SLOTB, qr, o, carry, dd, f0);
            if (jt <= jdiag && __all(carry > 134.0f)) { done = true; if (lane == 0) done_at[wid] = it; }
        }
        slot = nslot;
    }
#undef SB_DMA
    {   LAS unsigned short* stg = (LAS unsigned short*)(shm + LDS_OST + wid * 4096);
#pragma unroll
        for (int r = 0; r < 16; ++r) { const int orow = crow(r, hi);
#pragma unroll
            for (int d0 = 0; d0 < 2; ++d0) stg[orow * 64 + d0 * 32 + r32] = (unsigned short)f2bf(o[d0][r]); }
        asm volatile("s_waitcnt lgkmcnt(0)" ::: "memory");
        bf16* Ow = OSB + (rowbase + t0w) * 512 + h * 64;
#pragma unroll
        for (int i = 0; i < 4; ++i) { const int row = i * 8 + (lane >> 3), ch = lane & 7; const u32x4 v = *(const LAS u32x4*)(stg + row * 64 + ch * 8); *(u32x4*)(Ow + (long)row * 512 + ch * 8) = v; }
    }
    asm volatile("s_waitcnt lgkmcnt(0)\n\ts_barrier" ::: "memory");
}
}

#ifndef IDX_DEBUG
#define IDX_DEBUG 0
#endif
#ifndef VMID_ITERS
#define VMID_ITERS 0
#endif
namespace idx {
using att::bf16x8; using att::f32x16;
constexpr int PITCH = NPROJ;
#define IDX_DPP(v, ctrl) __builtin_amdgcn_update_dpp(0, (v), (ctrl), 0xF, 0xF, true)
__device__ __forceinline__ int wave_sum_i(int v) {
    v += IDX_DPP(v, 0xB1); v += IDX_DPP(v, 0x4E); v += IDX_DPP(v, 0x141); v += IDX_DPP(v, 0x140);
    return __builtin_amdgcn_readlane(v, 0) + __builtin_amdgcn_readlane(v, 16) + __builtin_amdgcn_readlane(v, 32) + __builtin_amdgcn_readlane(v, 48);
}
__device__ __forceinline__ unsigned umax_(unsigned a, unsigned b) { return a > b ? a : b; }
__device__ __forceinline__ unsigned umin_(unsigned a, unsigned b) { return a < b ? a : b; }
__device__ __forceinline__ unsigned wave_max_u(unsigned v) {
    v = umax_(v, (unsigned)IDX_DPP((int)v, 0xB1)); v = umax_(v, (unsigned)IDX_DPP((int)v, 0x4E)); v = umax_(v, (unsigned)IDX_DPP((int)v, 0x141)); v = umax_(v, (unsigned)IDX_DPP((int)v, 0x140));
    return umax_(umax_((unsigned)__builtin_amdgcn_readlane((int)v, 0), (unsigned)__builtin_amdgcn_readlane((int)v, 16)), umax_((unsigned)__builtin_amdgcn_readlane((int)v, 32), (unsigned)__builtin_amdgcn_readlane((int)v, 48)));
}
__device__ __forceinline__ unsigned wave_min_u(unsigned v) {
    v = umin_(v, (unsigned)IDX_DPP((int)v, 0xB1)); v = umin_(v, (unsigned)IDX_DPP((int)v, 0x4E)); v = umin_(v, (unsigned)IDX_DPP((int)v, 0x141)); v = umin_(v, (unsigned)IDX_DPP((int)v, 0x140));
    return umin_(umin_((unsigned)__builtin_amdgcn_readlane((int)v, 0), (unsigned)__builtin_amdgcn_readlane((int)v, 16)), umin_((unsigned)__builtin_amdgcn_readlane((int)v, 32), (unsigned)__builtin_amdgcn_readlane((int)v, 48)));
}
__device__ __forceinline__ unsigned f2key(float v) { unsigned u = __float_as_uint(v); u = (u == 0x80000000u) ? 0u : u; return (u & 0x80000000u) ? ~u : (u | 0x80000000u); }
__device__ __forceinline__ float key2f(unsigned k) { return __uint_as_float((k & 0x80000000u) ? (k & 0x7fffffffu) : ~k); }


#define IDX_DPPB(v, ctrl, rmask) __builtin_amdgcn_update_dpp(0, (v), (ctrl), (rmask), 0xF, false)
__device__ __forceinline__ int wave_incl_scan_i(int v) {
    v += __builtin_amdgcn_update_dpp(0, v, 0x111, 0xF, 0xF, true); v += __builtin_amdgcn_update_dpp(0, v, 0x112, 0xF, 0xF, true);
    v += __builtin_amdgcn_update_dpp(0, v, 0x114, 0xF, 0xF, true); v += __builtin_amdgcn_update_dpp(0, v, 0x118, 0xF, 0xF, true);
    v += IDX_DPPB(v, 0x142, 0xA); v += IDX_DPPB(v, 0x143, 0xC);
    return v;
}
__device__ __forceinline__ float wave_max_f(float v) {
    v = fmaxf(v, __int_as_float(IDX_DPP(__float_as_int(v), 0xB1))); v = fmaxf(v, __int_as_float(IDX_DPP(__float_as_int(v), 0x4E)));
    v = fmaxf(v, __int_as_float(IDX_DPP(__float_as_int(v), 0x141))); v = fmaxf(v, __int_as_float(IDX_DPP(__float_as_int(v), 0x140)));
    const int b = __float_as_int(v);
    return fmaxf(fmaxf(__int_as_float(__builtin_amdgcn_readlane(b, 0)), __int_as_float(__builtin_amdgcn_readlane(b, 16))), fmaxf(__int_as_float(__builtin_amdgcn_readlane(b, 32)), __int_as_float(__builtin_amdgcn_readlane(b, 48))));
}
__device__ __forceinline__ float wave_min_f(float v) {
    v = fminf(v, __int_as_float(IDX_DPP(__float_as_int(v), 0xB1))); v = fminf(v, __int_as_float(IDX_DPP(__float_as_int(v), 0x4E)));
    v = fminf(v, __int_as_float(IDX_DPP(__float_as_int(v), 0x141))); v = fminf(v, __int_as_float(IDX_DPP(__float_as_int(v), 0x140)));
    const int b = __float_as_int(v);
    return fminf(fminf(__int_as_float(__builtin_amdgcn_readlane(b, 0)), __int_as_float(__builtin_amdgcn_readlane(b, 16))), fminf(__int_as_float(__builtin_amdgcn_readlane(b, 32)), __int_as_float(__builtin_amdgcn_readlane(b, 48))));
}
typedef int i32x4 __attribute__((ext_vector_type(4)));
__device__ __forceinline__ void hist_scan(LAS int* hist, int lane, int target, int& bstar, int& above, int& cnt) {
    const i32x4 h = *(const LAS i32x4*)(hist + 252 - 4 * lane);
    const int s = (h.x + h.y) + (h.z + h.w);
    const int P = wave_incl_scan_i(s);
    const int L = __builtin_ctzll(__ballot(P >= target));
    const int d0 = __builtin_amdgcn_readlane(h.w, L), d1 = __builtin_amdgcn_readlane(h.z, L), d2 = __builtin_amdgcn_readlane(h.y, L), d3 = __builtin_amdgcn_readlane(h.x, L);
    int E = __builtin_amdgcn_readlane(P, L) - __builtin_amdgcn_readlane(s, L), j;
    if (E + d0 >= target) { j = 0; cnt = d0; } else { E += d0; if (E + d1 >= target) { j = 1; cnt = d1; } else { E += d1; if (E + d2 >= target) { j = 2; cnt = d2; } else { E += d2; j = 3; cnt = d3; } } }
    bstar = 255 - 4 * L - j; above = E;
}
typedef short i16x2 __attribute__((ext_vector_type(2)));
template <int NG>
__device__ __forceinline__ int select_fast2(const LAS float* srow0, int t, int lane, unsigned long long (&mybits)[2], unsigned (&br_lo)[2], unsigned (&br_hi)[2]) {
    const int tl = t - lane;
    const LAS float* srow[2] = {srow0, srow0 + 2048};
    float vmax[2], vmin[2], S[2]; i16x2 pc[2][4 * NG]; int ok = 3;
#pragma unroll
    for (int r = 0; r < 2; ++r) {
        const float fill = srow[r][0]; float v[8 * NG]; float mx = fill, mn = fill;
#pragma unroll
        for (int i = 0; i < 8 * NG; ++i) { float val = srow[r][64 * i + lane]; if (i >= 8 * (NG - 1)) val = (64 * i <= tl + r) ? val : fill; v[i] = val; mx = fmaxf(mx, val); mn = fminf(mn, val); }
        mx = wave_max_f(mx); mn = wave_min_f(mn); vmax[r] = mx; vmin[r] = mn; br_lo[r] = 0u; br_hi[r] = 0u;
        if (!(mx > mn)) { ok &= ~(1 << r); S[r] = 0.f; } else S[r] = 32767.0f / (mx - mn);
#pragma unroll
        for (int j = 0; j < 4 * NG; ++j) {
            int c0 = (int)((v[2 * j] - mn) * S[r]), c1 = (int)((v[2 * j + 1] - mn) * S[r]);
            if (j >= 4 * (NG - 1)) { c0 = (64 * (2 * j) <= tl + r) ? c0 : -1; c1 = (64 * (2 * j + 1) <= tl + r) ? c1 : -1; }
            pc[r][j] = __builtin_amdgcn_cvt_pk_i16(c0, c1);
        }
    }
    int lo[2] = {0, 0}, hi[2] = {32768, 32768}, lo256[2] = {-1, -1};
#pragma unroll
    for (int it = 0; it < 15; ++it) {
#pragma unroll
        for (int r = 0; r < 2; ++r) {
            const int m = (lo[r] + hi[r]) >> 1;
            const i16x2 mm = {(short)m, (short)m};
            i16x2 a0 = {0, 0}, a1 = {0, 0};
#pragma unroll
            for (int g = 0; g < NG; ++g) {
                a0 += ((pc[r][4 * g + 0] - mm) >> 15) + ((pc[r][4 * g + 1] - mm) >> 15);
                a1 += ((pc[r][4 * g + 2] - mm) >> 15) + ((pc[r][4 * g + 3] - mm) >> 15);
            }
            const i16x2 a = a0 + a1;
            const int c = 512 * NG + wave_sum_i((int)a.x + (int)a.y);
            const bool ge = c >= 256;
            lo256[r] = (c == 256) ? m : lo256[r];
            lo[r] = ge ? m : lo[r]; hi[r] = ge ? hi[r] : m;
        }
    }
#pragma unroll
    for (int r = 0; r < 2; ++r) {
        if (lo256[r] < 0) {
            if ((ok >> r) & 1) { const float w = (vmax[r] - vmin[r]) * (1.0f / 32767.0f); br_lo[r] = f2key(vmin[r] + ((float)lo[r] - 1.0f) * w); br_hi[r] = f2key(vmin[r] + ((float)lo[r] + 2.0f) * w); }
            ok &= ~(1 << r);
        }
        mybits[r] = 0ull;
    }
#pragma unroll
    for (int j = 0; j < 4 * NG; ++j)
#pragma unroll
        for (int r = 0; r < 2; ++r) {
            const unsigned long long b0 = __ballot((int)pc[r][j].x >= lo256[r] && lo256[r] >= 0), b1 = __ballot((int)pc[r][j].y >= lo256[r] && lo256[r] >= 0);
            if (lane == 2 * j) mybits[r] = b0;
            if (lane == 2 * j + 1) mybits[r] = b1;
        }
    return ok;
}
__device__ __forceinline__ void select_bisect(const LAS float* srow, int t, int lane, unsigned long long& mybits, int pmode = 0, unsigned* dbg = nullptr, unsigned br_lo = 0u, unsigned br_hi = 0u) {
    unsigned k[32];
    const int ng = (t >> 9) + 1;
    unsigned vmax = 0u, vmin = 0xffffffffu;
#pragma unroll
    for (int g = 0; g < 4; ++g) {
        if (g < ng) {
#pragma unroll
            for (int i = 8 * g; i < 8 * g + 8; ++i) { const int s = 64 * i + lane; const unsigned kk = f2key(srow[s]); k[i] = (s <= t) ? kk : 0u;
                vmax = umax_(vmax, k[i]); vmin = umin_(vmin, k[i] ? k[i] : 0xffffffffu); }
        } else {
#pragma unroll
            for (int i = 8 * g; i < 8 * g + 8; ++i) k[i] = 0u;
        }
    }
    unsigned lo_k = wave_min_u(vmin), hi_k = wave_max_u(vmax) + 1u;
    if (pmode == 1) { if (lane < 32) { const int lo = 64 * lane; mybits = (lo + 63 <= t) ? ~0ull : ((lo > t) ? 0ull : ((1ull << (t - lo + 1)) - 1ull)); if (lo_k == 0x12345u && hi_k == 0x54321u) mybits ^= 1ull; } return; }
    auto cnt_ge = [&](unsigned m) -> int {
        const int ms = (int)(m ^ 0x80000000u);
        int n0 = 0, n1 = 0, n2 = 0, n3 = 0;
#pragma unroll
        for (int g = 0; g < 4; ++g) if (g < ng) {
            n0 += (__builtin_elementwise_sub_sat((int)(k[8 * g + 0] ^ 0x80000000u), ms) >> 31) + (__builtin_elementwise_sub_sat((int)(k[8 * g + 1] ^ 0x80000000u), ms) >> 31);
            n1 += (__builtin_elementwise_sub_sat((int)(k[8 * g + 2] ^ 0x80000000u), ms) >> 31) + (__builtin_elementwise_sub_sat((int)(k[8 * g + 3] ^ 0x80000000u), ms) >> 31);
            n2 += (__builtin_elementwise_sub_sat((int)(k[8 * g + 4] ^ 0x80000000u), ms) >> 31) + (__builtin_elementwise_sub_sat((int)(k[8 * g + 5] ^ 0x80000000u), ms) >> 31);
            n3 += (__builtin_elementwise_sub_sat((int)(k[8 * g + 6] ^ 0x80000000u), ms) >> 31) + (__builtin_elementwise_sub_sat((int)(k[8 * g + 7] ^ 0x80000000u), ms) >> 31);
        }
        return 512 * ng + wave_sum_i((n0 + n1) + (n2 + n3));
    };
    int c_lo = t + 1, c_hi = 0; int nit = 0;
    if (br_hi > br_lo) {
        const unsigned bl = umax_(br_lo, lo_k), bh = umin_(br_hi, hi_k);
        if (bh > bl) { const int cl = cnt_ge(bl), ch = cnt_ge(bh); if (cl >= 256 && ch < 256) { lo_k = bl; hi_k = bh; c_lo = cl; c_hi = ch; } }
    }
    const int eq_it = (br_hi > br_lo) ? 0 : 14;
    for (int it = 0; hi_k - lo_k > 1u && !(pmode == 2 && it >= 4); ++it) { ++nit;
        if (it == eq_it && c_lo != 256) {
            unsigned vs = 0xffffffffu;
#pragma unroll
            for (int g = 0; g < 4; ++g) if (g < ng) {
#pragma unroll
                for (int i = 8 * g; i < 8 * g + 8; ++i) vs = umin_(vs, (k[i] >= lo_k) ? k[i] : 0xffffffffu);
            }
            vs = wave_min_u(vs);
            if (cnt_ge(vs + 1u) == c_hi) { lo_k = vs; hi_k = vs + 1u; break; }
        }
        unsigned m = lo_k + ((hi_k - lo_k) >> 1);
        if (it < VMID_ITERS) { const unsigned mv = f2key(0.5f * (key2f(lo_k) + key2f(hi_k))); if (mv > lo_k && mv < hi_k) m = mv; }
        const int c = cnt_ge(m);
        if (c >= 256) { lo_k = m; c_lo = c; if (c == 256) break; } else { hi_k = m; c_hi = c; }
    }
    mybits = 0ull;
#if IDX_DEBUG
    if (lane == 0 && dbg) atomicAdd(dbg + 1, (unsigned)nit);
#endif
    if (pmode >= 3) { if (lane < 32) { const int lo = 64 * lane; mybits = (lo + 63 <= t) ? ~0ull : ((lo > t) ? 0ull : ((1ull << (t - lo + 1)) - 1ull)); if (lo_k == 0x12345u && c_lo == 77777) mybits ^= 1ull; } return; }
    if (c_lo == 256) {
#pragma unroll
        for (int g = 0; g < 4; ++g) if (g < ng) {
#pragma unroll
            for (int i = 8 * g; i < 8 * g + 8; ++i) { const unsigned long long bal = __ballot(k[i] >= lo_k); if (lane == i) mybits = bal; }
        }
    } else {
        int remaining = 256 - c_hi;
#pragma unroll
        for (int i = 0; i < 32; ++i) if ((i >> 3) < ng) {
            const unsigned long long gt = __ballot(k[i] > lo_k), eq = __ballot(k[i] == lo_k);
            const int rank = (int)__builtin_amdgcn_mbcnt_hi((unsigned)(eq >> 32), __builtin_amdgcn_mbcnt_lo((unsigned)eq, 0u));
            const unsigned long long take = __ballot((k[i] == lo_k) && (rank < remaining));
            const int ne = __builtin_popcountll(eq); remaining -= (ne < remaining) ? ne : remaining;
            if (lane == i) mybits = gt | take;
        }
    }
}

__device__ __forceinline__ void idx_unit(int b, int tb, const bf16* PROJ, unsigned* MASK, LAS unsigned char* shm, LAS int* hist, int tid, int skip_sel = 0, unsigned* dbg = nullptr) {
    const int lane = tid & 63, r32 = lane & 31, hi = lane >> 5; const int wid = __builtin_amdgcn_readfirstlane(tid >> 6);
    const long rowbase = (long)b * SEQ; const int t0 = tb * 16;
    LAS float* sc = (LAS float*)shm;
    if (t0 + 15 >= 256) {
        bf16x8 A[2][4]; float wv[2][4][4];
#pragma unroll
        for (int mb = 0; mb < 2; ++mb) {
            const bf16* qrow = PROJ + (rowbase + t0 + 8 * mb + (r32 >> 2)) * PITCH + C_IQ + (r32 & 3) * 64 + 8 * hi;
#pragma unroll
            for (int ks = 0; ks < 4; ++ks) A[mb][ks] = *reinterpret_cast<const bf16x8*>(qrow + 16 * ks);
#pragma unroll
            for (int g = 0; g < 4; ++g) { const bf16* wrow = PROJ + (rowbase + t0 + 8 * mb + 2 * g + hi) * PITCH + C_IW;
#pragma unroll
                for (int hh = 0; hh < 4; ++hh) wv[mb][g][hh] = bf2f(wrow[hh]) * 0.0625f; }
        }
        const int nkb = ((t0 + 15) >> 5) + 1;
        for (int kb = wid; kb < nkb; kb += 8) {
            const int s = 32 * kb + r32;
            const bf16* krow = PROJ + (rowbase + s) * PITCH + C_IK + 8 * hi;
            bf16x8 B[4];
#pragma unroll
            for (int ks = 0; ks < 4; ++ks) B[ks] = *reinterpret_cast<const bf16x8*>(krow + 16 * ks);
#pragma unroll
            for (int mb = 0; mb < 2; ++mb) {
                f32x16 acc = {};
#pragma unroll
                for (int ks = 0; ks < 4; ++ks) acc = __builtin_amdgcn_mfma_f32_32x32x16_bf16(A[mb][ks], B[ks], acc, 0, 0, 0);
#pragma unroll
                for (int g = 0; g < 4; ++g) {
                    float v = 0.f;
#pragma unroll
                    for (int hh = 0; hh < 4; ++hh) v += fmaxf(acc[4 * g + hh], 0.f) * wv[mb][g][hh];
                    sc[(8 * mb + 2 * g + hi) * 2048 + s] = v;
                }
            }
        }
    }
    __syncthreads();
    unsigned long long mb2[2] = {0ull, 0ull}; unsigned brl[2] = {0u, 0u}, brh[2] = {0u, 0u}; int ok2 = 0;
    {   const int tp = t0 + 2 * wid;
        if (tp >= 256 && skip_sel == 0) {
            const int ng = (tp >> 9) + 1; const LAS float* sp = sc + (2 * wid) * 2048;
            if (ng == 1) ok2 = select_fast2<1>(sp, tp, lane, mb2, brl, brh); else if (ng == 2) ok2 = select_fast2<2>(sp, tp, lane, mb2, brl, brh);
            else if (ng == 3) ok2 = select_fast2<3>(sp, tp, lane, mb2, brl, brh); else ok2 = select_fast2<4>(sp, tp, lane, mb2, brl, brh);
        }
    }
#pragma unroll 1
    for (int rr = 0; rr < (skip_sel == 1 ? 0 : 2); ++rr) {
        const int q = 2 * wid + rr, t = t0 + q;
        unsigned long long mybits = rr ? mb2[1] : mb2[0];
        if (t >= 256 && skip_sel >= 3) { select_bisect(sc + q * 2048, t, lane, mybits, skip_sel - 2); } else
        if (t < 256 || skip_sel == 2) {
            mybits = 0ull;
            if (lane < 32) { const int lo = 64 * lane; mybits = (lo + 63 <= t) ? ~0ull : ((lo > t) ? 0ull : ((1ull << (t - lo + 1)) - 1ull)); }
        } else {
            bool okf = (ok2 >> rr) & 1;
#if IDX_DEBUG
            const unsigned long long fastbits = mybits; const bool okf_dbg = okf; okf = false;
            if (!okf_dbg && lane == 0) atomicAdd(dbg + 1, 100u);
#endif
            if (!okf) select_bisect(sc + q * 2048, t, lane, mybits, 0, nullptr, rr ? brl[1] : brl[0], rr ? brh[1] : brh[0]);
#if IDX_DEBUG
            if (okf_dbg && __any(lane < 32 && fastbits != mybits) && lane == 0) atomicAdd(dbg + 0, 1u);
#endif
        }
        if (lane < 32) *(unsigned long long*)(MASK + (rowbase + t) * 64 + 2 * lane) = mybits;
    }
    __syncthreads();
}
#undef IDX_DPP

__device__ __forceinline__ void kvdec_unit(int u, const bf16* PROJ, const bf16* WKVT, bf16* KD, bf16* VD, LAS unsigned char* shm, int tid) {
    const int lane = tid & 63, r32 = lane & 31, hi = lane >> 5; const int wid = __builtin_amdgcn_readfirstlane(tid >> 6);
    const int mr = wid >> 2, nc = wid & 3; const long m0 = (long)u * 64 + 32 * mr;
    const bf16* arow = PROJ + (m0 + r32) * PITCH + C_KVL + 8 * hi;
    const bf16* brow = WKVT + (32 * nc + r32) * 256 + 8 * hi;
    f32x16 acc = {}; float ss = 0.f;
#pragma unroll
    for (int kc = 0; kc < 4; ++kc) {
        bf16x8 a[4], bb[4];
#pragma unroll
        for (int j = 0; j < 4; ++j) { a[j] = *reinterpret_cast<const bf16x8*>(arow + 16 * (4 * kc + j)); bb[j] = *reinterpret_cast<const bf16x8*>(brow + 16 * (4 * kc + j)); }
#pragma unroll
        for (int j = 0; j < 4; ++j) {
#pragma unroll
            for (int e = 0; e < 8; ++e) { const float f = bf2f((unsigned short)a[j][e]); ss += f * f; }
            acc = __builtin_amdgcn_mfma_f32_32x32x16_bf16(a[j], bb[j], acc, 0, 0, 0);
        }
    }
    { const auto rr = __builtin_amdgcn_permlane32_swap(__float_as_uint(ss), __float_as_uint(ss), false, false); ss = __uint_as_float(rr[0]) + __uint_as_float(rr[1]); }
    LAS float* rs = (LAS float*)(shm + wid * 128);
    if (hi == 0) rs[r32] = rsqrtf(ss * (1.f / KV_LORA) + RMS_EPS);
    asm volatile("s_waitcnt lgkmcnt(0)" ::: "memory");
    bf16* dst = (nc < 2 ? KD : VD) + (nc & 1) * 32 + r32;
#pragma unroll
    for (int r = 0; r < 16; ++r) { const int row = att::crow(r, hi); dst[(m0 + row) * 64] = (bf16)f2bf(acc[r] * rs[row]); }
    asm volatile("s_waitcnt lgkmcnt(0)" ::: "memory");
}
}

namespace att {
constexpr int DSA_OST = NSLOT * SLOTB;
constexpr int DSA_WSF = DSA_OST + 32768;
constexpr int DSA_MSK = DSA_WSF + 1024;
constexpr int DSA_LDS_BYTES = DSA_MSK + 32 * 264;
constexpr float DSA_THR = 8.0f;
__device__ __forceinline__ void dsa_tile(lds_cptr kp, lds_cptr vp, const bf16x8 (&qr)[4], f32x16 (&o)[2], float& m_run, float& l, unsigned long long mbits, float slope2, float bl, int hi, int r32,
                                         LAS float* wsf) {
    f32x16 y[2];
#pragma unroll
    for (int p = 0; p < 2; ++p)
#pragma unroll
        for (int r = 0; r < 16; ++r) y[p][r] = __builtin_fmaf(slope2, (float)(32 * p + (r & 3) + 8 * (r >> 2)), bl);
#pragma unroll
    for (int d0 = 0; d0 < 4; ++d0) {
        const bf16x8 b0 = *(const __attribute__((address_space(3))) bf16x8*)(kp + d0 * 2048);
        const bf16x8 b1 = *(const __attribute__((address_space(3))) bf16x8*)(kp + d0 * 2048 + 512);
        y[0] = __builtin_amdgcn_mfma_f32_32x32x16_bf16(b0, qr[d0], y[0], 0, 0, 0); y[1] = __builtin_amdgcn_mfma_f32_32x32x16_bf16(b1, qr[d0], y[1], 0, 0, 0);
    }
    const unsigned ninf = 0xff800000u;
    const int w0 = (int)((unsigned)mbits >> (4 * hi)), w1 = (int)((unsigned)(mbits >> 32) >> (4 * hi));
    float cm = -INFINITY;
#pragma unroll
    for (int p = 0; p < 2; ++p)
#pragma unroll
        for (int r = 0; r < 16; ++r) {
            const unsigned mm = (unsigned)__builtin_amdgcn_sbfe(p ? w1 : w0, (r & 3) + 8 * (r >> 2), 1);
            const float v = __uint_as_float((__float_as_uint(y[p][r]) & mm) | (ninf & ~mm));
            y[p][r] = v; cm = fmaxf(cm, v);
        }
    { const auto rr = __builtin_amdgcn_permlane32_swap(__float_as_uint(cm), __float_as_uint(cm), false, false); cm = fmaxf(__uint_as_float(rr[0]), __uint_as_float(rr[1])); }
    const bool need = cm > m_run + DSA_THR;
    if (__any(need)) {
        const float alpha = need ? __builtin_amdgcn_exp2f(m_run - cm) : 1.0f;
        m_run = need ? cm : m_run; l *= alpha;
        if (hi == 0) wsf[r32] = alpha;
#pragma unroll
        for (int r = 0; r < 16; ++r) { const float a = wsf[crow(r, hi)]; o[0][r] *= a; o[1][r] *= a; }
    }
    const float m_safe = (m_run == -INFINITY) ? 0.f : m_run;
    u32x4 pw[4]; float ls = 0.f;
#pragma unroll
    for (int p = 0; p < 2; ++p)
#pragma unroll
        for (int g = 0; g < 4; ++g) {
            float a[4];
#pragma unroll
            for (int i = 0; i < 4; ++i) { a[i] = __builtin_amdgcn_exp2f(y[p][4 * g + i] - m_safe); ls += a[i]; }
            pw[2 * p + (g >> 1)][(g & 1) * 2 + 0] = cvtpk(a[0], a[1]);
            pw[2 * p + (g >> 1)][(g & 1) * 2 + 1] = cvtpk(a[2], a[3]);
        }
    l += ls;
#pragma unroll
    for (int d0 = 0; d0 < 2; ++d0)
#pragma unroll
        for (int ks = 0; ks < 4; ++ks) {
            const s16x4 lo = vtr(vp + d0 * 4096 + ks * 1024), hi4 = vtr(vp + d0 * 4096 + ks * 1024 + 512);
            const bf16x8 vf = {lo[0], lo[1], lo[2], lo[3], hi4[0], hi4[1], hi4[2], hi4[3]};
            o[d0] = __builtin_amdgcn_mfma_f32_32x32x16_bf16(__builtin_bit_cast(bf16x8, pw[ks]), vf, o[d0], 0, 0, 0);
        }
}
__device__ __forceinline__ void norm_row_512(const u32x4 v, const float* gain, bf16* dst, int lane) {
    float f[8];
#pragma unroll
    for (int e = 0; e < 4; ++e) { f[2 * e] = __uint_as_float(v[e] << 16); f[2 * e + 1] = __uint_as_float(v[e] & 0xffff0000u); }
    float ss = 0.f;
#pragma unroll
    for (int e = 0; e < 8; ++e) ss += f[e] * f[e];
    const float rstd = rsqrtf(wave_sum(ss) * (1.f / 512.f) + RMS_EPS);
    const f32x4 g0 = *(const f32x4*)(gain + lane * 8), g1 = *(const f32x4*)(gain + lane * 8 + 4);
    u32x4 w; w.x = cvtpk(f[0] * rstd * g0.x, f[1] * rstd * g0.y); w.y = cvtpk(f[2] * rstd * g0.z, f[3] * rstd * g0.w); w.z = cvtpk(f[4] * rstd * g1.x, f[5] * rstd * g1.y); w.w = cvtpk(f[6] * rstd * g1.z, f[7] * rstd * g1.w);
    *(u32x4*)(dst + lane * 8) = w;
}
__device__ __forceinline__ void dsa_unit(int b, int qb32, const bf16* PROJ, const bf16* KD, const bf16* VD, const unsigned* MASK, const bf16* OSB, const float* gsb, const float* gdsa, bf16* OCAT,
                                         LAS unsigned char* shm, int tid) {
    const int lane = tid & 63, r32 = lane & 31, hi = lane >> 5; const int wid = __builtin_amdgcn_readfirstlane(tid >> 6);
    const long rowbase = (long)b * SEQ; const int t0 = qb32 * 32;
    const bf16* Qw = PROJ + (rowbase + t0) * PITCH + C_DQ + wid * 64;
    const unsigned lds0 = (unsigned)(unsigned long)shm;
    const bf16* ksrc = KD + (rowbase + lane) * 64 + wid * 8;
    const bf16* vsrc = VD + (rowbase + 16 * (wid & 3) + (lane >> 2)) * 64 + (wid >> 2) * 32 + (lane & 3) * 8;
    const unsigned kdst = lds0 + wid * 1024, vdst = lds0 + VOFF + wid * 1024;
#define DSA_DMA(t, slot) do { glds16(ksrc + (long)(t) * 64 * 64, (unsigned)__builtin_amdgcn_readfirstlane(kdst + (slot) * SLOTB)); \
                              glds16(vsrc + (long)(t) * 64 * 64, (unsigned)__builtin_amdgcn_readfirstlane(vdst + (slot) * SLOTB)); } while (0)
    const lds_cptr shm3 = (lds_cptr)shm;
    const lds_cptr kp0 = shm3 + hi * 1024 + r32 * 16;
    const lds_cptr vp0 = shm3 + VOFF + ((lane >> 4) & 1) * 32 + (lane & 3) * 8 + (4 * hi + ((lane & 15) >> 2)) * 64;
    LAS float* wsf = (LAS float*)(shm + DSA_WSF) + wid * 32;
    const int NT = (t0 >> 6) + 1;
    DSA_DMA(0, 0);
    bf16x8 qr[4];
#pragma unroll
    for (int d0 = 0; d0 < 4; ++d0) qr[d0] = *reinterpret_cast<const bf16x8*>(&Qw[(long)r32 * PITCH + d0 * 16 + hi * 8]);
    {   const int row = tid >> 4, ch = tid & 15; const u32x4 v = *(const u32x4*)(MASK + (rowbase + t0 + row) * 64 + ch * 4);
        LAS unsigned long long* d = (LAS unsigned long long*)(shm + DSA_MSK + row * 264 + ch * 16);
        d[0] = (unsigned long long)v.x | ((unsigned long long)v.y << 32); d[1] = (unsigned long long)v.z | ((unsigned long long)v.w << 32); }
    const LAS unsigned long long* mrow = (const LAS unsigned long long*)(shm + DSA_MSK + r32 * 264);
    const float slope2 = __builtin_amdgcn_exp2f(-(float)(wid + 1)) * LOG2E;
    float bl = -slope2 * (float)(t0 + r32 - 4 * hi);
    f32x16 o[2]; o[0] = f32x16{}; o[1] = f32x16{};
    float m_run = -INFINITY, l = 0.f;
    int slot = 0;
    for (int jt = 0; jt < NT; ++jt) {
        const int nslot = (slot == NSLOT - 1) ? 0 : slot + 1;
        if (jt + 1 < NT) { DSA_DMA(jt + 1, nslot); ATT_WAIT_BAR(2); } else { ATT_WAIT_BAR(0); }
        const unsigned long long mcur = mrow[jt];
        dsa_tile(kp0 + slot * SLOTB, vp0 + slot * SLOTB, qr, o, m_run, l, mcur, slope2, bl, hi, r32, wsf);
        bl += 64.0f * slope2; slot = nslot;
    }
#undef DSA_DMA
    { const auto rr = __builtin_amdgcn_permlane32_swap(__float_as_uint(l), __float_as_uint(l), false, false); l = __uint_as_float(rr[0]) + __uint_as_float(rr[1]); }
    if (hi == 0) wsf[r32] = __builtin_amdgcn_rcpf(l);
    LAS unsigned short* ost = (LAS unsigned short*)(shm + DSA_OST);
#pragma unroll
    for (int r = 0; r < 16; ++r) { const int row = crow(r, hi); const float rl = wsf[row];
#pragma unroll
        for (int d0 = 0; d0 < 2; ++d0) ost[row * 512 + wid * 64 + d0 * 32 + r32] = (unsigned short)f2bf(o[d0][r] * rl); }
    asm volatile("s_waitcnt lgkmcnt(0)\n\ts_barrier" ::: "memory");
#pragma unroll
    for (int i = 0; i < 4; ++i) {
        const int row = 4 * wid + i; const long m = rowbase + t0 + row;
        const u32x4 vd = *(const LAS u32x4*)(ost + row * 512 + lane * 8);
        const u32x4 vs = *(const u32x4*)(OSB + m * 512 + lane * 8);
        norm_row_512(vs, gsb, OCAT + m * 1024, lane);
        norm_row_512(vd, gdsa, OCAT + m * 1024 + 512, lane);
    }
    asm volatile("s_waitcnt lgkmcnt(0)\n\ts_barrier" ::: "memory");
}
}

__global__ void __launch_bounds__(NWAVES * 64, 2) mega(Args args) {
    extern __shared__ __attribute__((aligned(16))) unsigned char lds[];
    LAS unsigned char* L = (LAS unsigned char*)lds;
    volatile LAS unsigned* MISC = (volatile LAS unsigned*)(L + MISC_OFF);
    const int G = gridDim.x, bx = blockIdx.x;
    const int vcu = (G % 8 == 0) ? (bx % 8) * (G / 8) + bx / 8 : bx;
    unsigned char* ws = args.ws;
    gu32* ctl = (gu32*)(ws + WS_CTL);
    for (int u = threadIdx.x; u < (LDS_BYTES - LDSCTL_OFF) / 4; u += NWAVES * 64) ((LAS unsigned*)(L + LDSCTL_OFF))[u] = 0u;
    __syncthreads();
    XcdBarrier bar; bar.bar = (unsigned*)(ctl + CW_BAR); bar.x = 0; bar.st = nullptr;
    const bool multi = (args.ph_hi - args.ph_lo) > 1;
    if (multi) bar = xcd_barrier_post((unsigned*)(ctl + CW_BAR), MISC + 8);

    float* mod0 = (float*)(ws + WS_MOD); float* modf = mod0 + 2 * 8 * 6144;
    bf16* XN = (bf16*)(ws + WS_XN); bf16* PROJ = (bf16*)(ws + WS_PROJ); bf16* OCAT = (bf16*)(ws + WS_OCAT);
    const int NGW = G * NWAVES;

    int rep_left = args.rep_n; bool first = true;
    for (int ph = args.ph_lo; ph < args.ph_hi; (ph == args.rep_ph && rep_left > 0) ? --rep_left : ++ph) {
        if (!first) xcd_barrier(bar);
        first = false;
        int tid = threadIdx.x; asm volatile("" : "+v"(tid));
        const int lane = tid & 63, wave = __builtin_amdgcn_readfirstlane(tid >> 6), gw = vcu * NWAVES + wave;
        if (ph == PH_PRO) {
            LAS float* scr = (LAS float*)(L + RING_OFF + wave * 8448);
            constexpr int I_IN = 16 * 88, I_O = 16 * 32, I_G = 16 * 88, I_D = 44 * 32, I_LAYER = I_IN + I_O + 2 * I_G + I_D;
            for (int it = gw; it < DEPTH * I_LAYER; it += NGW) {
                const int l = it / I_LAYER; int r = it % I_LAYER;
                if (r < I_IN) { transpose_item(args.in[6] + (size_t)l * 1024 * IN_COLS, 1024, IN_COLS, (bf16*)(ws + WS_WIN + l * WIN_BYTES), scr, r / 88, r % 88, lane, RowId{}); continue; } r -= I_IN;
                if (r < I_O) { transpose_item(args.in[12] + (size_t)l * 1024 * 1024, 1024, 1024, (bf16*)(ws + WS_WO + l * WO_BYTES), scr, r / 32, r % 32, lane, RowId{}); continue; } r -= I_O;
                if (r < I_G) { transpose_item(args.in[13] + (size_t)l * 1024 * D_FF, 1024, D_FF, (bf16*)(ws + WS_WGU + l * WGU_BYTES), scr, r / 88, r % 88, lane, RowGU{0}); continue; } r -= I_G;
                if (r < I_G) { transpose_item(args.in[14] + (size_t)l * 1024 * D_FF, 1024, D_FF, (bf16*)(ws + WS_WGU + l * WGU_BYTES), scr, r / 88, r % 88, lane, RowGU{1}); continue; } r -= I_G;
                transpose_item(args.in[15] + (size_t)l * D_FF * 1024, D_FF, 1024, (bf16*)(ws + WS_WD + l * WD_BYTES), scr, r / 32, r % 32, lane, RowId{});
            }
            for (int i = gw * 64 + lane; i < DEPTH * 128 * 256; i += NGW * 64) { const int ll = i >> 15, n = (i >> 8) & 127, j = i & 255;
                const float w = (n < 64) ? args.in[8][(size_t)ll * 256 * 64 + j * 64 + n] : args.in[9][(size_t)ll * 256 * 64 + j * 64 + (n - 64)];
                ((bf16*)(ws + WS_WKV))[i] = (bf16)f2bf(w * args.in[7][ll * 256 + j]); }
            __syncthreads();
            LAS float* cact = (LAS float*)(L + 0);
            LAS float* red = (LAS float*)(L + 32768);
            for (int i = tid; i < 8192; i += NWAVES * 64) { const float v = args.in[1][i]; cact[i] = v / (1.f + __expf(-v)); }
            __syncthreads();
            constexpr int NIT = (2 * 6144 + 2048) / 64;
            for (int it = vcu; it < NIT; it += G) {
                const float* W; const float* bias; float* outp; int N, n0;
                if (it < 96) { W = args.in[2]; bias = args.in[3]; outp = mod0; N = 6144; n0 = it * 64; }
                else if (it < 192) { W = args.in[2] + (size_t)1024 * 6144; bias = args.in[3] + 6144; outp = mod0 + 8 * 6144; N = 6144; n0 = (it - 96) * 64; }
                else { W = args.in[16]; bias = args.in[17]; outp = modf; N = 2048; n0 = (it - 192) * 64; }
                float acc[8];
#pragma unroll
                for (int b = 0; b < 8; ++b) acc[b] = 0.f;
                const float* wp = W + (size_t)(wave * 128) * N + n0 + lane;
#pragma unroll 4
                for (int k = 0; k < 128; ++k) { const float w = wp[(size_t)k * N];
#pragma unroll
                    for (int b = 0; b < 8; ++b) acc[b] += cact[b * 1024 + wave * 128 + k] * w; }
#pragma unroll
                for (int b = 0; b < 8; ++b) red[(wave * 8 + b) * 64 + lane] = acc[b];
                __syncthreads();
                { const int b = wave; float s = 0.f;
#pragma unroll
                  for (int w = 0; w < 8; ++w) s += red[(w * 8 + b) * 64 + lane];
                  outp[(size_t)b * N + n0 + lane] = s + bias[n0 + lane]; }
                __syncthreads();
            }
        } else if (ph == PH_FINAL) {
            float scl = 1.0f;
#if IDX_DEBUG
            { const unsigned c0 = ((const unsigned*)(ws + WS_CTL))[100], c1 = ((const unsigned*)(ws + WS_CTL))[101]; scl = (c0 ? __builtin_nanf("") : 1.0f) * (1.0f + (float)c1 / 2867200.0f); }
#endif
            for (int m = gw; m < M; m += NGW) { const int b = m / SEQ; normmod_row_f32(args.out + (size_t)m * D_MODEL, args.in[18], modf + (size_t)b * 2048, modf + (size_t)b * 2048 + 1024, args.out + (size_t)m * D_MODEL, lane, scl); }
        } else {
            const int l = (ph - PH_L0) / NSP, sp = (ph - PH_L0) % NSP;
            const float* mod = mod0 + (size_t)l * 8 * 6144;
            if (sp == SP_NORM1 || sp == SP_NORM2) {
                const float* xin = (sp == SP_NORM1 && l == 0) ? args.in[0] : args.out;
                const float* gain = (sp == SP_NORM1 ? args.in[4] : args.in[5]) + l * 1024;
                const int o = (sp == SP_NORM1) ? 0 : 3072;
                for (int m = gw; m < M; m += NGW) { const int b = m / SEQ; normmod_row_bf16(xin + (size_t)m * D_MODEL, gain, mod + (size_t)b * 6144 + o, mod + (size_t)b * 6144 + o + 1024, XN + (size_t)m * D_MODEL, lane); }
            } else if (sp == SP_INPROJ) {
                pg8::Gemm g{XN, (const bf16*)(ws + WS_WIN + l * WIN_BYTES), M, NPROJ, 1024}; pg8::StaticOrder S; S.init(M, NPROJ, G, bx);
                pg8::EpiProj E{PROJ, NPROJ, C2};
                pg8::gemm_phase<pg8::EpiProj, pg8::StaticOrder, true, true>(L + RING_OFF, g, S, E, tid);
            } else if (sp == SP_OUTPROJ) {
                pg8::Gemm g{OCAT, (const bf16*)(ws + WS_WO + l * WO_BYTES), M, 1024, 1024}; pg8::StaticOrder S; S.init(M, 1024, G, bx);
                pg8::EpiResid E{l == 0 ? args.in[0] : args.out, args.out, 1024, mod + 2048, 6144};
                pg8::gemm_phase<pg8::EpiResid, pg8::StaticOrder, true, true>(L + RING_OFF, g, S, E, tid);
            } else if (sp == SP_GATEUP) {
                pg8::Gemm g{XN, (const bf16*)(ws + WS_WGU + l * WGU_BYTES), M, NGU, 1024}; pg8::StaticOrder S; S.init(M, NGU, G, bx);
                pg8::EpiSwiGLU E{PROJ, D_FF};
                pg8::gemm_phase<pg8::EpiSwiGLU, pg8::StaticOrder, true, true>(L + RING_OFF, g, S, E, tid);
            } else if (sp == SP_DOWN) {
                pg8::Gemm g{PROJ, (const bf16*)(ws + WS_WD + l * WD_BYTES), M, 1024, D_FF}; pg8::StaticOrder S; S.init(M, 1024, G, bx);
                pg8::EpiResid E{args.out, args.out, 1024, mod + 5120, 6144};
                pg8::gemm_phase<pg8::EpiResid, pg8::StaticOrder, true, true>(L + RING_OFF, g, S, E, tid);
            }
            else if (sp == SP_MIX1 && !(REP_MODE >= 2 && ph == args.rep_ph && rep_left > 0)) {
                for (int u = vcu; u < 512; u += G) { const int pi = u & 255, bh = pi >> 2, p = pi & 3, qb = (u >> 8) ? 7 - p : p;
                    att::sb_unit(bh >> 3, bh & 7, qb, PROJ, (bf16*)(ws + WS_OSB), L + RING_OFF, tid); }
            }
            if (sp == SP_MIX1 && !(REP_MODE == 1 && ph == args.rep_ph && rep_left > 0)) {
                for (int u = vcu; u < 1024; u += G) { const int k = u >> 8, v = u & 255, bb = v >> 5, j = v & 31; const int tb = (k == 0) ? j : (k == 1) ? 63 - j : (k == 2) ? 64 + j : 127 - j;
                    idx::idx_unit(bb, tb, PROJ, (unsigned*)(ws + WS_MASK), L + RING_OFF, (LAS int*)(L + LDSCTL_OFF + 1024 + wave * 1056 + 16), tid, (REP_MODE >= 3 && ph == args.rep_ph && rep_left > 0) ? REP_MODE - 2 : 0, (unsigned*)(ws + WS_CTL) + 100); }
                for (int u = vcu; u < 256; u += G) idx::kvdec_unit(u, PROJ, (const bf16*)(ws + WS_WKV) + (size_t)l * 128 * 256, (bf16*)(ws + WS_KD), (bf16*)(ws + WS_VD), L + RING_OFF, tid);
            }
            if (sp == SP_MIX2) {
                for (int u = vcu; u < 512; u += G) { const int v = u & 255, bb = v >> 5, j = v & 31, qb32 = (u >> 8) ? 63 - j : j;
                    att::dsa_unit(bb, qb32, PROJ, (const bf16*)(ws + WS_KD), (const bf16*)(ws + WS_VD), (const unsigned*)(ws + WS_MASK), (const bf16*)(ws + WS_OSB),
                                  args.in[10] + l * 512, args.in[11] + l * 512, OCAT, L + RING_OFF, tid); }
            }
        }
    }
}

__global__ void __launch_bounds__(256) k_sb_attn_bf(const bf16* __restrict__ proj, bf16* __restrict__ osb) {
    __shared__ float qs[4][64];
    const int tid = threadIdx.x, lane = tid & 63, w = tid >> 6;
    const int wv = blockIdx.x * 4 + w;
    const int t = wv % SEQ, bh = wv / SEQ, h = bh % 8, b = bh / 8;
    const size_t mrow = (size_t)b * SEQ;
    qs[w][lane] = bf2f(proj[(mrow + t) * NPROJ + C_SBQ + h * 64 + lane]);
    __syncthreads();
    float carry = 0.f, o = 0.f;
    for (int s_hi = t - 1; s_hi >= 0; s_hi -= 64) {
        const int s = s_hi - lane; const bool valid = s >= 0;
        float y = 0.f;
        if (valid) { const bf16* kr = proj + (mrow + s) * NPROJ + C_SBK + h * 64; float d = 0.f;
#pragma unroll
            for (int i = 0; i < 64; ++i) d += qs[w][i] * bf2f(kr[i]);
            y = d; }
        const float lg = fmaxf(y, 0.f) + log2f(1.f + exp2f(-fabsf(y)));
        const float Lb = valid ? -lg : 0.f;
        float incl = Lb;
#pragma unroll
        for (int off = 1; off < 64; off <<= 1) { const float n = __shfl_up(incl, off); if (lane >= off) incl += n; }
        const float tail = carry + (incl - Lb);
        const float Aw = valid ? exp2f((y - lg) + tail) : 0.f;
        carry += __shfl(incl, 63);
        const int nvalid = (s_hi + 1 < 64) ? s_hi + 1 : 64;
        for (int j = 0; j < nvalid; ++j) { const float a = __shfl(Aw, j); o += a * bf2f(proj[(mrow + (s_hi - j)) * NPROJ + C_SBV + h * 64 + lane]); }
    }
    osb[(mrow + t) * 512 + h * 64 + lane] = (bf16)f2bf(o);
}
__global__ void __launch_bounds__(256) k_idx_bf(const bf16* __restrict__ proj, unsigned* __restrict__ mask) {
    __shared__ float qi[256];
    __shared__ float wi[4];
    __shared__ float score[SEQ];
    const int m = blockIdx.x, t = m % SEQ, b = m / SEQ, tid = threadIdx.x, lane = tid & 63;
    const size_t mrow = (size_t)b * SEQ;
    qi[tid] = bf2f(proj[(size_t)m * NPROJ + C_IQ + tid]);
    if (tid < 4) wi[tid] = bf2f(proj[(size_t)m * NPROJ + C_IW + tid]) * 0.5f;
    __syncthreads();
    const int n = t + 1;
    for (int s = tid; s < n; s += 256) {
        const bf16* kr = proj + (mrow + s) * NPROJ + C_IK;
        float d[4] = {0.f, 0.f, 0.f, 0.f};
#pragma unroll 8
        for (int i = 0; i < 64; ++i) { const float kv = bf2f(kr[i]);
#pragma unroll
            for (int hh = 0; hh < 4; ++hh) d[hh] += qi[hh * 64 + i] * kv; }
        float sc = 0.f;
#pragma unroll
        for (int hh = 0; hh < 4; ++hh) sc += fmaxf(d[hh] * 0.125f, 0.f) * wi[hh];
        score[s] = sc;
    }
    __syncthreads();
    for (int base = 0; base < SEQ; base += 256) {
        const int s = base + tid; bool sel = false;
        if (s < n) {
            if (n <= 256) sel = true;
            else { const float v = score[s]; int rank = 0;
                for (int j = 0; j < n; ++j) { const float u = score[j]; rank += (u > v || (u == v && j < s)) ? 1 : 0; }
                sel = rank < 256; }
        }
        const unsigned long long bal = __ballot(sel);
        if (lane == 0) { mask[(size_t)m * 64 + (s >> 5)] = (unsigned)bal; mask[(size_t)m * 64 + (s >> 5) + 1] = (unsigned)(bal >> 32); }
    }
}
__global__ void k_kvdec_bf(const bf16* __restrict__ proj, const float* __restrict__ kvg, const float* __restrict__ wuk, const float* __restrict__ wuv, bf16* __restrict__ kd, bf16* __restrict__ vd) {
    __shared__ float kvn[256];
    __shared__ float red[2];
    const int m = blockIdx.x, tid = threadIdx.x;
    const bf16* row = proj + (size_t)m * NPROJ + C_KVL;
    const float a = bf2f(row[tid]), b = bf2f(row[tid + 128]);
    float ss = a * a + b * b;
    for (int o = 32; o > 0; o >>= 1) ss += __shfl_xor(ss, o);
    if ((tid & 63) == 0) red[tid >> 6] = ss;
    __syncthreads();
    const float rstd = rsqrtf((red[0] + red[1]) * (1.f / KV_LORA) + RMS_EPS);
    kvn[tid] = a * rstd * kvg[tid]; kvn[tid + 128] = b * rstd * kvg[tid + 128];
    __syncthreads();
    const float* w = (tid < 64) ? wuk : wuv; const int n = tid & 63;
    float acc = 0.f;
    for (int j = 0; j < 256; ++j) acc += kvn[j] * w[j * 64 + n];
    if (tid < 64) kd[(size_t)m * 64 + n] = (bf16)f2bf(acc); else vd[(size_t)m * 64 + n] = (bf16)f2bf(acc);
}
__global__ void __launch_bounds__(256) k_dsa_bf(const bf16* __restrict__ proj, const bf16* __restrict__ kd, const bf16* __restrict__ vd, const unsigned* __restrict__ mask, bf16* __restrict__ odsa) {
    __shared__ float qs[4][64];
    const int tid = threadIdx.x, lane = tid & 63, w = tid >> 6;
    const int wv = blockIdx.x * 4 + w;
    const int h = wv % 8, m = wv / 8, t = m % SEQ, b = m / SEQ;
    const size_t mrow = (size_t)b * SEQ;
    qs[w][lane] = bf2f(proj[(size_t)m * NPROJ + C_DQ + h * 64 + lane]);
    __syncthreads();
    const float slope = exp2f(-(float)(h + 1)) * LOG2E;
    float mrun = -INFINITY, l = 0.f, o = 0.f;
    for (int s0 = 0; s0 <= t; s0 += 64) {
        const unsigned w0 = mask[(size_t)m * 64 + (s0 >> 5)], w1 = mask[(size_t)m * 64 + (s0 >> 5) + 1];
        const unsigned long long bits = ((unsigned long long)w1 << 32) | w0;
        if (bits == 0ull) continue;
        const int s = s0 + lane; const bool sel = (bits >> lane) & 1ull;
        float logit = -INFINITY;
        if (sel) { const bf16* kr = kd + (mrow + s) * 64; float d = 0.f;
#pragma unroll
            for (int i = 0; i < 64; ++i) d += qs[w][i] * bf2f(kr[i]);
            logit = d - slope * (float)(t - s); }
        float cmax = logit;
        for (int off = 32; off > 0; off >>= 1) cmax = fmaxf(cmax, __shfl_xor(cmax, off));
        const float nm = fmaxf(mrun, cmax);
        const float alpha = exp2f(mrun - nm);
        const float p = sel ? exp2f(logit - nm) : 0.f;
        float ps = p;
        for (int off = 32; off > 0; off >>= 1) ps += __shfl_xor(ps, off);
        l = l * alpha + ps; o *= alpha; mrun = nm;
        for (int j = 0; j < 64; ++j) if ((bits >> j) & 1ull) { const float pj = __shfl(p, j); o += pj * bf2f(vd[(mrow + s0 + j) * 64 + lane]); }
    }
    odsa[(size_t)m * 512 + h * 64 + lane] = (bf16)f2bf(o / l);
}
__global__ void k_outnorm_bf(const bf16* __restrict__ osb, const bf16* __restrict__ odsa, const float* __restrict__ gsb, const float* __restrict__ gdsa, bf16* __restrict__ ocat) {
    __shared__ float red[4];
    const int m = blockIdx.x, tid = threadIdx.x;
    const bf16* src = (tid < 128) ? osb + (size_t)m * 512 + tid * 4 : odsa + (size_t)m * 512 + (tid - 128) * 4;
    float v[4]; float ss = 0.f;
#pragma unroll
    for (int j = 0; j < 4; ++j) { v[j] = bf2f(src[j]); ss += v[j] * v[j]; }
    for (int o = 32; o > 0; o >>= 1) ss += __shfl_xor(ss, o);
    if ((tid & 63) == 0) red[tid >> 6] = ss;
    __syncthreads();
    const float tot = (tid < 128) ? (red[0] + red[1]) : (red[2] + red[3]);
    const float rstd = rsqrtf(tot * (1.f / 512.f) + RMS_EPS);
    const float* g = (tid < 128) ? gsb + tid * 4 : gdsa + (tid - 128) * 4;
#pragma unroll
    for (int j = 0; j < 4; ++j) ocat[(size_t)m * 1024 + tid * 4 + j] = (bf16)f2bf(v[j] * rstd * g[j]);
}

extern "C" void kernel_launch(void* const* d_in, const int* in_sizes, int n_in, void* d_out, int out_size, void* d_ws, size_t ws_size, hipStream_t stream) {
    static int grid = 0;
    if (grid == 0) {
        if (n_in != 19 || out_size != M * D_MODEL || ws_size < WS_END) { fprintf(stderr, "kernel_launch: unexpected problem shape (n_in %d out %d ws %zu)\n", n_in, out_size, ws_size); grid = -1; return; }
        int dev = 0, cus = 0;
        if (hipGetDevice(&dev) != hipSuccess || hipDeviceGetAttribute(&cus, hipDeviceAttributeMultiprocessorCount, dev) != hipSuccess) { grid = -1; return; }
        if (hipFuncSetAttribute((const void*)mega, hipFuncAttributeMaxDynamicSharedMemorySize, LDS_BYTES) != hipSuccess) { fprintf(stderr, "kernel_launch: hipFuncSetAttribute failed\n"); grid = -1; return; }
        (void)hipGetLastError();
        grid = cus;
    }
    if (grid < 0) return;
    (void)hipMemsetAsync((char*)d_ws + WS_CTL, 0, CTL_ZERO_BYTES, stream);
    Args a{};
    for (int i = 0; i < 19; ++i) a.in[i] = (const float*)d_in[i];
    a.out = (float*)d_out; a.ws = (unsigned char*)d_ws;
    char* ws = (char*)d_ws;
    const bf16* PROJ = (const bf16*)(ws + WS_PROJ);
    auto run = [&](int lo, int hi) { a.ph_lo = lo; a.ph_hi = hi; hipLaunchKernelGGL(mega, dim3(grid), dim3(NWAVES * 64), LDS_BYTES, stream, a); };
    a.rep_ph = REP_PH; a.rep_n = REP_N;
    (void)PROJ; run(PH_PRO, NPHASE);
}
```
